# Optimizing an MI355X kernel written in HIP

```python
import jax, jax.numpy as jnp
from jax import lax
import numpy as np

D_MODEL = 2048
BATCH = 8
SEQ = 2048
DEPTH = 2

GRID_W = 64
CTX_LEN = 256
HEAD_DIM = 128
N_Q_HEADS = D_MODEL // (2 * HEAD_DIM)
N_KV_HEADS = 2
GQA_GROUP = N_Q_HEADS // N_KV_HEADS
ATTN_WIDTH = N_Q_HEADS * HEAD_DIM
KV_WIDTH = N_KV_HEADS * HEAD_DIM
WINDOW = 128
BLOCK = 128
ROPE_BASE = 10000.0
ROT_AXIS_DIM = HEAD_DIM // 2
POOL_WINDOWS = (2, 4, 8, 16)
N_POOL_GROUPS = len(POOL_WINDOWS)
POOL_WIDTH = D_MODEL // 4
POOL_GROUP_DIM = POOL_WIDTH // N_POOL_GROUPS
SGU_WIDTH = D_MODEL // 4
N_SGU_HEADS = 4
SGU_HEAD_DIM = SGU_WIDTH // N_SGU_HEADS
SGU_CHUNK = 128
MIX_WIDTH = ATTN_WIDTH + POOL_WIDTH + SGU_WIDTH
Q_END = ATTN_WIDTH
K_END = Q_END + KV_WIDTH
V_END = K_END + KV_WIDTH
P_END = V_END + POOL_WIDTH
U_END = P_END + SGU_WIDTH
IN_WIDTH = U_END + SGU_WIDTH
D_FF = ((8 * D_MODEL // 3 + 255) // 256) * 256
CONV_WIDTH = 3
N_MOD = 6
EPS = 1e-6

kernel_name = "hybrid_parallel_heads_dit_block"


def rms_norm(x, g):
    xf = x.astype(jnp.float32)
    y = xf * lax.rsqrt(jnp.mean(xf * xf, axis=-1, keepdims=True) + EPS)
    return (y * g.astype(jnp.float32)).astype(x.dtype)


def modulate(h, shift, scale):
    return h * (1 + scale) + shift


def axial_rope_tables(L):
    rows = L // GRID_W
    row_ids = jnp.repeat(jnp.arange(rows), GRID_W).astype(jnp.float32)
    col_ids = jnp.tile(jnp.arange(GRID_W), rows).astype(jnp.float32)
    inv = 1.0 / (ROPE_BASE ** (jnp.arange(0, ROT_AXIS_DIM, 2, dtype=jnp.float32) / ROT_AXIS_DIM))
    ang_r = row_ids[:, None] * inv
    ang_c = col_ids[:, None] * inv
    return jnp.cos(ang_r), jnp.sin(ang_r), jnp.cos(ang_c), jnp.sin(ang_c)


def rotate_half_pairs(x, cos, sin):
    half = x.shape[-1] // 2
    x1, x2 = x[..., :half], x[..., half:]
    cos = cos[None, :, None, :]
    sin = sin[None, :, None, :]
    return jnp.concatenate([x1 * cos - x2 * sin, x2 * cos + x1 * sin], axis=-1)


def apply_axial_rope(x, tables):
    cr, sr, cc, sc = tables
    xf = x.astype(jnp.float32)
    yr = rotate_half_pairs(xf[..., :ROT_AXIS_DIM], cr, sr)
    yc = rotate_half_pairs(xf[..., ROT_AXIS_DIM:], cc, sc)
    return jnp.concatenate([yr, yc], axis=-1).astype(x.dtype)


def split_proj(p):
    return jnp.split(p, [Q_END, K_END, V_END, P_END, U_END], axis=-1)


def latent_window_attention(q, k, v, kc, vc, sink):
    B, L = q.shape[0], q.shape[1]
    nb = L // BLOCK
    scale = HEAD_DIM ** -0.5
    qb = q.reshape(B, nb, BLOCK, N_KV_HEADS, GQA_GROUP, HEAD_DIM)
    pad = ((0, 0), (1, 1), (0, 0), (0, 0), (0, 0))
    kp = jnp.pad(k.reshape(B, nb, BLOCK, N_KV_HEADS, HEAD_DIM), pad)
    vp = jnp.pad(v.reshape(B, nb, BLOCK, N_KV_HEADS, HEAD_DIM), pad)
    kband = jnp.concatenate([kp[:, :-2], kp[:, 1:-1], kp[:, 2:]], axis=2)
    vband = jnp.concatenate([vp[:, :-2], vp[:, 1:-1], vp[:, 2:]], axis=2)
    s_band = jnp.einsum('bnqkgd,bnskd->bnkgqs', qb, kband).astype(jnp.float32) * scale
    qi = jnp.arange(nb)[:, None] * BLOCK + jnp.arange(BLOCK)[None, :]
    kj = (jnp.arange(nb)[:, None] - 1) * BLOCK + jnp.arange(3 * BLOCK)[None, :]
    valid = ((kj[:, None, :] >= 0) & (kj[:, None, :] < L)
             & (jnp.abs(qi[:, :, None] - kj[:, None, :]) <= WINDOW))
    s_band = jnp.where(valid[None, :, None, None], s_band, -jnp.inf)
    s_ctx = jnp.einsum('bnqkgd,bskd->bnkgqs', qb, kc).astype(jnp.float32) * scale
    s_sink = jnp.broadcast_to(
        sink.astype(jnp.float32).reshape(N_KV_HEADS, GQA_GROUP)[None, None, :, :, None, None],
        s_band.shape[:-1] + (1,))
    p = jax.nn.softmax(jnp.concatenate([s_band, s_ctx, s_sink], axis=-1), axis=-1)
    nband = 3 * BLOCK
    nctx = kc.shape[1]
    p_band = p[..., :nband].astype(v.dtype)
    p_ctx = p[..., nband:nband + nctx].astype(v.dtype)
    o = (jnp.einsum('bnkgqs,bnskd->bnqkgd', p_band, vband)
         + jnp.einsum('bnkgqs,bskd->bnqkgd', p_ctx, vc))
    return o.reshape(B, L, ATTN_WIDTH)


def context_attention(qc, kc, vc, sink):
    B, Lc = qc.shape[0], qc.shape[1]
    qg = qc.reshape(B, Lc, N_KV_HEADS, GQA_GROUP, HEAD_DIM)
    s = jnp.einsum('bqkgd,bskd->bkgqs', qg, kc).astype(jnp.float32) * (HEAD_DIM ** -0.5)
    s_sink = jnp.broadcast_to(
        sink.astype(jnp.float32).reshape(N_KV_HEADS, GQA_GROUP)[None, :, :, None, None],
        s.shape[:-1] + (1,))
    p = jax.nn.softmax(jnp.concatenate([s, s_sink], axis=-1), axis=-1)[..., :-1]
    o = jnp.einsum('bkgqs,bskd->bqkgd', p.astype(vc.dtype), vc)
    return o.reshape(B, Lc, ATTN_WIDTH)


def multiscale_pool(pv, pool_w, pool_scale):
    B, L, _ = pv.shape
    xf = pv.astype(jnp.float32).reshape(B, L, N_POOL_GROUPS, POOL_GROUP_DIM)
    cs = jnp.pad(jnp.cumsum(xf, axis=1), ((0, 0), (1, 0), (0, 0), (0, 0)))
    t = jnp.arange(L)
    means = []
    for gi, w in enumerate(POOL_WINDOWS):
        lo = jnp.clip(t - w // 2, 0, L)
        hi = jnp.clip(t - w // 2 + w, 0, L)
        s = cs[:, hi, gi] - cs[:, lo, gi]
        means.append(s / (hi - lo).astype(jnp.float32)[None, :, None])
    pooled = jnp.stack(means, axis=2)
    y = (pooled - xf).astype(pv.dtype)
    y = jnp.einsum('blgc,gcd->blgd', y, pool_w)
    return y.reshape(B, L, POOL_WIDTH) * pool_scale


def spatial_gating(u, v, g_norm, w_s, b_s):
    B, L, _ = u.shape
    u = jax.nn.gelu(u, approximate=False)
    v = rms_norm(jax.nn.gelu(v, approximate=False), g_norm)
    vch = v.reshape(B, L // SGU_CHUNK, SGU_CHUNK, N_SGU_HEADS, SGU_HEAD_DIM)
    vs = jnp.einsum('hpq,bnqhc->bnphc', w_s, vch) + b_s.T[:, :, None]
    return u * vs.reshape(B, L, SGU_WIDTH)


def conv_ffn(h, w_up, conv_w, conv_b, w_down):
    L = h.shape[1]
    a = h @ w_up
    ap = jnp.pad(a, ((0, 0), (1, 1), (0, 0)))
    a = conv_b + ap[:, 0:L] * conv_w[0] + ap[:, 1:L + 1] * conv_w[1] + ap[:, 2:L + 2] * conv_w[2]
    gate, val = jnp.split(a, 2, axis=-1)
    return (jax.nn.silu(gate) * val) @ w_down


def setup_inputs(seed: int = 0) -> dict:
    key = jax.random.key(seed)
    ks = jax.random.split(key, 24)
    D = D_MODEL

    def nrm(k, shape, s):
        return jax.random.normal(k, shape, jnp.float32) * s

    return {
        "x": nrm(ks[0], (BATCH, SEQ, D), 1.0),
        "c": nrm(ks[1], (BATCH, D), 1.0),
        "ctx": nrm(ks[2], (BATCH, CTX_LEN, D), 1.0),
        "c_ctx": nrm(ks[3], (D,), 1.0),
        "norm1_g": 1.0 + nrm(ks[4], (DEPTH, D), 0.02),
        "norm2_g": 1.0 + nrm(ks[5], (DEPTH, D), 0.02),
        "w_ada": nrm(ks[6], (DEPTH, D, N_MOD * D), D ** -0.5),
        "b_ada": nrm(ks[7], (DEPTH, N_MOD * D), 0.02),
        "w_in": nrm(ks[8], (DEPTH, D, IN_WIDTH), D ** -0.5),
        "q_norm_g": 1.0 + nrm(ks[9], (DEPTH, HEAD_DIM), 0.02),
        "k_norm_g": 1.0 + nrm(ks[10], (DEPTH, HEAD_DIM), 0.02),
        "attn_sink": nrm(ks[11], (DEPTH, N_Q_HEADS), 0.5),
        "pool_w": nrm(ks[12], (DEPTH, N_POOL_GROUPS, POOL_GROUP_DIM, POOL_GROUP_DIM), POOL_GROUP_DIM ** -0.5),
        "pool_scale": 1.0 + nrm(ks[13], (DEPTH, POOL_WIDTH), 0.02),
        "sgu_norm_g": 1.0 + nrm(ks[14], (DEPTH, SGU_WIDTH), 0.02),
        "sgu_w": nrm(ks[15], (DEPTH, N_SGU_HEADS, SGU_CHUNK, SGU_CHUNK), SGU_CHUNK ** -0.5),
        "sgu_b": 1.0 + nrm(ks[16], (DEPTH, N_SGU_HEADS, SGU_CHUNK), 0.02),
        "w_out": nrm(ks[17], (DEPTH, MIX_WIDTH, D), MIX_WIDTH ** -0.5),
        "w_up": nrm(ks[18], (DEPTH, D, 2 * D_FF), D ** -0.5),
        "conv_w": nrm(ks[19], (DEPTH, CONV_WIDTH, 2 * D_FF), CONV_WIDTH ** -0.5),
        "conv_b": nrm(ks[20], (DEPTH, 2 * D_FF), 0.02),
        "w_down": nrm(ks[21], (DEPTH, D_FF, D), D_FF ** -0.5),
        "final_norm_g": 1.0 + nrm(ks[22], (D,), 0.02),
    }


def reference(x, c, ctx, c_ctx, norm1_g, norm2_g, w_ada, b_ada, w_in, q_norm_g, k_norm_g,
              attn_sink, pool_w, pool_scale, sgu_norm_g, sgu_w, sgu_b, w_out, w_up, conv_w,
              conv_b, w_down, final_norm_g):
    B, L, D = x.shape
    Lc = ctx.shape[1]
    rope = axial_rope_tables(L)
    silu_c = jax.nn.silu(c)
    silu_cc = jax.nn.silu(c_ctx)
    xc = ctx
    for l in range(DEPTH):
        last = l == DEPTH - 1
        mod = (silu_c @ w_ada[l] + b_ada[l]).reshape(B, N_MOD, 1, D)
        mod_c = (silu_cc @ w_ada[l] + b_ada[l]).reshape(N_MOD, D)

        h = modulate(rms_norm(x, norm1_g[l]), mod[:, 0], mod[:, 1])
        hc = modulate(rms_norm(xc, norm1_g[l]), mod_c[0], mod_c[1])
        q, k, v, pv, u, g = split_proj(h @ w_in[l])
        qc, kc, vc, pvc, uc, gc = split_proj(hc @ w_in[l])

        q = apply_axial_rope(rms_norm(q.reshape(B, L, N_Q_HEADS, HEAD_DIM), q_norm_g[l]), rope)
        k = apply_axial_rope(rms_norm(k.reshape(B, L, N_KV_HEADS, HEAD_DIM), k_norm_g[l]), rope)
        v = v.reshape(B, L, N_KV_HEADS, HEAD_DIM)
        kc = rms_norm(kc.reshape(B, Lc, N_KV_HEADS, HEAD_DIM), k_norm_g[l])
        vc = vc.reshape(B, Lc, N_KV_HEADS, HEAD_DIM)

        attn = latent_window_attention(q, k, v, kc, vc, attn_sink[l])
        pool = multiscale_pool(pv, pool_w[l], pool_scale[l])
        sgu = spatial_gating(u, g, sgu_norm_g[l], sgu_w[l], sgu_b[l])
        mix = jnp.concatenate([attn, pool, sgu], axis=-1) @ w_out[l]
        x = x + mod[:, 2] * mix

        if not last:
            qc = rms_norm(qc.reshape(B, Lc, N_Q_HEADS, HEAD_DIM), q_norm_g[l])
            attn_c = context_attention(qc, kc, vc, attn_sink[l])
            pool_c = multiscale_pool(pvc, pool_w[l], pool_scale[l])
            sgu_c = spatial_gating(uc, gc, sgu_norm_g[l], sgu_w[l], sgu_b[l])
            mix_c = jnp.concatenate([attn_c, pool_c, sgu_c], axis=-1) @ w_out[l]
            xc = xc + mod_c[2] * mix_c

        hf = modulate(rms_norm(x, norm2_g[l]), mod[:, 3], mod[:, 4])
        x = x + mod[:, 5] * conv_ffn(hf, w_up[l], conv_w[l], conv_b[l], w_down[l])
        if not last:
            hfc = modulate(rms_norm(xc, norm2_g[l]), mod_c[3], mod_c[4])
            xc = xc + mod_c[5] * conv_ffn(hfc, w_up[l], conv_w[l], conv_b[l], w_down[l])

    return rms_norm(x, final_norm_g)
```

```cpp
#define REP_MASK 0u
#define EXTRA_SYNCS 0
#include <hip/hip_runtime.h>
#include <hip/hip_cooperative_groups.h>
#include <cstdio>
#include <cstdint>
namespace cg = cooperative_groups;
namespace pg8 {
#define PG8_LAS __attribute__((address_space(3)))
typedef unsigned short bf16_t;
typedef short bf16x8 __attribute__((ext_vector_type(8)));
typedef float f32x4 __attribute__((ext_vector_type(4)));
typedef unsigned u32x4 __attribute__((ext_vector_type(4)));
constexpr int BM = 256, BK = 64, HALF = 128, HTB = HALF * BK * 2  , STAGE_BYTES = 8 * HTB, NXCD = 8, WGM = 4;

__host__ __device__ __forceinline__ int lds_byte(int r, int c) { const int st = (r >> 4) * 2 + (c >> 5), rr = r & 15, cc = c & 31, ob = rr * 64 + cc * 2; return st * 1024 + (ob ^ (((ob >> 9) & 1) << 5)); }
__host__ __device__ __forceinline__ void stage_rc(int b, int& R, int& C) { const int st = b / 1024, sb = b % 1024, swz = sb ^ (((sb >> 9) & 1) << 5); R = (st >> 1) * 16 + swz / 64; C = (st & 1) * 32 + (swz % 64) / 2; }
__host__ __device__ __forceinline__ int perm32(int rho) { const int n = rho >> 4, i = rho & 15; return 8 * (i >> 2) + 4 * n + (i & 3); }

struct Unit { int pm, pn, kt0, nkt, part, tidx; };
struct Gemm { const bf16_t* A; const bf16_t* Bt; int M, N, K; };

struct StaticOrder {
    int nM, nN, nwg, G, c;
    __host__ __device__ void init(int M, int N, int G_, int c_) { nM = M / BM; nN = N / BM; nwg = nM * nN; G = G_; c = c_; }
    __host__ __device__ bool next(int i, Unit& u) const {
        const long L = (long)i * G + c; if (L >= nwg) return false;
        int wgid = (int)L; { const int q = nwg / NXCD, r = nwg % NXCD, xcd = wgid % NXCD, off = wgid / NXCD; wgid = (xcd < r ? xcd * (q + 1) : r * (q + 1) + (xcd - r) * q) + off; }
        const int nig = WGM * nN, gid = wgid / nig, fm = gid * WGM, gsz = (nM - fm) < WGM ? (nM - fm) : WGM;
        u.pm = fm + ((wgid % nig) % gsz); u.pn = (wgid % nig) / gsz; u.kt0 = 0; u.nkt = nkt; u.part = 0; u.tidx = 0; return true;
    }
    int nkt = 0;
    int split = 0;
    __host__ __device__ bool next_split(int i, Unit& u) const {
        const int full = nwg / G;
        if (!split || i < full) return next(i, u);
        if (i > full) return false;
        const int x = c & 7, j = c >> 3, cp = (j >> 2) * 8 + x, quarter = j & 3;
        StaticOrder t = *this; t.c = cp;
        if (!t.next(full, u)) return false;
        u.nkt = nkt >> 2; u.kt0 = quarter * u.nkt; u.part = quarter; u.tidx = cp; return true;
    }
    __device__ __forceinline__ void a_ready(const Unit&) const {}
    __device__ __forceinline__ void done(const Unit&) const {}
};
typedef float f32x2 __attribute__((ext_vector_type(2)));
__device__ __forceinline__ f32x2 gelu_pk(f32x2 v) {
    const f32x2 av = __builtin_elementwise_abs(v), d = av * 0.2316418882f + 1.0f;
    f32x2 t; t.x = __builtin_amdgcn_rcpf(d.x); t.y = __builtin_amdgcn_rcpf(d.y);
    f32x2 q = t * 0.5307027145f + (-0.7265760135f); q = q * t + 0.7107068705f; q = q * t + (-0.142248368f); q = q * t + 0.127414796f; q = q * t;
    const f32x2 s = (v * v) * (-0.72134752044f);
    f32x2 e; e.x = __builtin_amdgcn_exp2f(s.x); e.y = __builtin_amdgcn_exp2f(s.y);
    const f32x2 m = v * (q * e), r = v - m;
    f32x2 o; o.x = v.x < 0.f ? m.x : r.x; o.y = v.y < 0.f ? m.y : r.y; return o;
}

template <class Epi, class Sched, bool ALIGN_EPI = false, bool SP2 = false>
__device__ __forceinline__ void gemm_phase(PG8_LAS unsigned char* lds, const Gemm g, const Sched& S, const Epi& E) {
    int tid = threadIdx.x; asm volatile("" : "+v"(tid)); const int wid = __builtin_amdgcn_readfirstlane(tid >> 6), lane = tid & 63, wr = wid >> 2, wc = wid & 3, fr = lane & 15, fq = lane >> 4;
    const int K = g.K;
    unsigned voffA[2], voffB[2];
#pragma unroll
    for (int i = 0; i < 2; ++i) { int R, C; stage_rc(tid * 16 + i * 8192, R, C); const int Rb = Epi::PERM ? ((R & ~31) + perm32(R & 31)) : R;
        const int Ra = Epi::ROWPERM ? (128 * ((R >> 6) & 1) + 8 * (R & 15) + ((R >> 4) & 3)) : R; voffA[i] = (unsigned)(Ra * K + C) * 2u; voffB[i] = (unsigned)(Rb * K + C) * 2u; }
    const size_t kstep = (size_t)(BK * 2);
    const size_t hstep = (size_t)HALF * K * 2;
    const size_t tstep = 2 * hstep; const size_t hstepA = Epi::ROWPERM ? (size_t)4 * K * 2 : hstep;
    const unsigned ldsw = (unsigned)wid * 1024u;
    const int aoff = lds_byte(wr * 64 + fr, fq * 8), boff = lds_byte(wc * 32 + fr, fq * 8);
#define PG8_SA(b, h) (((b) * 2 + (h)) * HTB)
#define PG8_SB(b, h) ((4 + (b) * 2 + (h)) * HTB)
#define PG8_STAGE(bufoff, gbase, voff) do { _Pragma("unroll") for (int _i = 0; _i < 2; ++_i) \
        __builtin_amdgcn_global_load_lds((const unsigned*)((const char*)(gbase) + (voff)[_i]), (PG8_LAS unsigned*)(lds + (bufoff) + ldsw + _i * 8192), 16, 0, 0); } while (0)
#define PG8_LDA(dst, b, h) do { _Pragma("unroll") for (int m = 0; m < 4; ++m) _Pragma("unroll") for (int k = 0; k < 2; ++k) dst[m][k] = *(const PG8_LAS bf16x8*)(lds + PG8_SA(b, h) + aoff + m * 2048 + k * 1024); } while (0)
#define PG8_LDB(dst, b, h) do { _Pragma("unroll") for (int n = 0; n < 2; ++n) _Pragma("unroll") for (int k = 0; k < 2; ++k) dst[n][k] = *(const PG8_LAS bf16x8*)(lds + PG8_SB(b, h) + boff + n * 2048 + k * 1024); } while (0)
#define PG8_MMA(ai, bj, At, Bt) do { __builtin_amdgcn_s_setprio(1); _Pragma("unroll") for (int m = 0; m < 4; ++m) _Pragma("unroll") for (int n = 0; n < 2; ++n) _Pragma("unroll") for (int k = 0; k < 2; ++k) \
        acc[ai][bj][m][n] = __builtin_amdgcn_mfma_f32_16x16x32_bf16(Bt[n][k], At[m][k], acc[ai][bj][m][n], 0, 0, 0); __builtin_amdgcn_s_setprio(0); } while (0)
#define PG8_WAIT_V(n) asm volatile("s_waitcnt vmcnt(" #n ")" ::: "memory")
#define PG8_WAIT_L(n) asm volatile("s_waitcnt lgkmcnt(" #n ")" ::: "memory")
#define PG8_BAR __builtin_amdgcn_s_barrier()
#define PG8_SCHED __builtin_amdgcn_sched_barrier(0)
    Unit cur, nxt; int ui = 0;
    if (!S.next_split(0, cur)) return;
    f32x4 acc[2][2][4][2];
#pragma unroll
    for (int a = 0; a < 2; ++a)
#pragma unroll
        for (int b = 0; b < 2; ++b)
#pragma unroll
            for (int m = 0; m < 4; ++m)
#pragma unroll
                for (int n = 0; n < 2; ++n) acc[a][b][m][n] = (f32x4){0.f, 0.f, 0.f, 0.f};
    bf16x8 At[4][2], B0[2][2], B1[2][2];
    const char* cA = (const char*)g.A + (size_t)cur.pm * tstep + (size_t)cur.kt0 * kstep; const char* cB = (const char*)g.Bt + (size_t)cur.pn * tstep + (size_t)cur.kt0 * kstep;
    S.a_ready(cur);
    if constexpr (SP2) {
        PG8_STAGE(PG8_SB(0, 0), cB, voffB); PG8_STAGE(PG8_SB(0, 1), cB + hstep, voffB); PG8_STAGE(PG8_SA(0, 0), cA, voffA); PG8_STAGE(PG8_SA(0, 1), cA + hstepA, voffA);
        if (wr == 1) PG8_BAR;
        PG8_WAIT_V(2); PG8_BAR;
        PG8_STAGE(PG8_SB(1, 0), cB + kstep, voffB); PG8_STAGE(PG8_SA(1, 0), cA + kstep, voffA); PG8_STAGE(PG8_SB(1, 1), cB + hstep + kstep, voffB);
        PG8_WAIT_V(6); PG8_BAR;
    } else {
        PG8_STAGE(PG8_SB(0, 0), cB, voffB); PG8_STAGE(PG8_SA(0, 0), cA, voffA); PG8_STAGE(PG8_SB(0, 1), cB + hstep, voffB); PG8_STAGE(PG8_SA(0, 1), cA + hstepA, voffA);
        if (wr == 1) PG8_BAR;
        PG8_WAIT_V(4); PG8_BAR;
        PG8_STAGE(PG8_SB(1, 0), cB + kstep, voffB); PG8_STAGE(PG8_SA(1, 0), cA + kstep, voffA); PG8_STAGE(PG8_SB(1, 1), cB + hstep + kstep, voffB);
        PG8_WAIT_V(6); PG8_BAR;
    }
    for (;;) {
        const bool has_next = S.next_split(ui + 1, nxt); const int nt = cur.nkt;
        const char* nA = has_next ? (const char*)g.A + (size_t)nxt.pm * tstep + (size_t)nxt.kt0 * kstep : cA; const char* nB = has_next ? (const char*)g.Bt + (size_t)nxt.pn * tstep + (size_t)nxt.kt0 * kstep : cB;
        for (int t = 0; t < nt; t += 2) {
            const bool last = (t == nt - 2);
            const char* a1 = cA + (size_t)(t + 1) * kstep;
            const char* a2 = last ? nA : cA + (size_t)(t + 2) * kstep; const char* b2 = last ? nB : cB + (size_t)(t + 2) * kstep;
            const char* a3 = a2 + kstep; const char* b3 = b2 + kstep;
            if (last && has_next) S.a_ready(nxt);
            if constexpr (SP2) {
            PG8_LDB(B0, 0, 0); PG8_LDB(B1, 0, 1); PG8_SCHED; PG8_LDA(At, 0, 0); PG8_STAGE(PG8_SA(1, 1), a1 + hstepA, voffA);
            PG8_WAIT_V(8); PG8_WAIT_L(0); PG8_BAR; PG8_MMA(0, 0, At, B0); PG8_MMA(0, 1, At, B1); PG8_BAR; PG8_SCHED;
            PG8_LDA(At, 0, 1); PG8_STAGE(PG8_SB(0, 0), b2, voffB); PG8_STAGE(PG8_SB(0, 1), b2 + hstep, voffB); PG8_STAGE(PG8_SA(0, 0), a2, voffA);
            PG8_WAIT_V(8); PG8_WAIT_L(0); PG8_BAR; PG8_MMA(1, 0, At, B0); PG8_MMA(1, 1, At, B1); PG8_BAR; PG8_SCHED;
            PG8_LDB(B0, 1, 0); PG8_LDB(B1, 1, 1); PG8_SCHED; PG8_LDA(At, 1, 0); PG8_STAGE(PG8_SA(0, 1), a2 + hstepA, voffA);
            PG8_WAIT_V(8); PG8_WAIT_L(0); PG8_BAR; PG8_MMA(0, 0, At, B0); PG8_MMA(0, 1, At, B1); PG8_BAR; PG8_SCHED;
            PG8_LDA(At, 1, 1); PG8_STAGE(PG8_SB(1, 0), b3, voffB); PG8_STAGE(PG8_SB(1, 1), b3 + hstep, voffB); PG8_STAGE(PG8_SA(1, 0), a3, voffA);
            PG8_WAIT_V(8); PG8_WAIT_L(0); PG8_BAR; PG8_MMA(1, 0, At, B0); PG8_MMA(1, 1, At, B1); PG8_BAR; PG8_SCHED;
            } else {
            PG8_LDB(B0, 0, 0); PG8_SCHED; PG8_LDA(At, 0, 0); PG8_STAGE(PG8_SA(1, 1), a1 + hstepA, voffA);
            PG8_WAIT_L(8); PG8_BAR; PG8_WAIT_L(0); PG8_MMA(0, 0, At, B0); PG8_BAR; PG8_SCHED;
            PG8_LDB(B1, 0, 1); PG8_STAGE(PG8_SB(0, 0), b2, voffB);
            PG8_BAR; PG8_WAIT_L(0); PG8_MMA(0, 1, At, B1); PG8_BAR;
            PG8_LDA(At, 0, 1); PG8_STAGE(PG8_SA(0, 0), a2, voffA);
            PG8_BAR; PG8_WAIT_L(0); PG8_MMA(1, 0, At, B0); PG8_BAR; PG8_SCHED;
            PG8_STAGE(PG8_SB(0, 1), b2 + hstep, voffB);
            PG8_WAIT_V(6); PG8_BAR; PG8_MMA(1, 1, At, B1); PG8_BAR;
            PG8_LDB(B0, 1, 0); PG8_SCHED; PG8_LDA(At, 1, 0); PG8_STAGE(PG8_SA(0, 1), a2 + hstepA, voffA);
            PG8_WAIT_L(8); PG8_BAR; PG8_WAIT_L(0); PG8_MMA(0, 0, At, B0); PG8_BAR; PG8_SCHED;
            PG8_LDB(B1, 1, 1); PG8_STAGE(PG8_SB(1, 0), b3, voffB);
            PG8_BAR; PG8_WAIT_L(0); PG8_MMA(0, 1, At, B1); PG8_BAR;
            PG8_LDA(At, 1, 1); PG8_STAGE(PG8_SA(1, 0), a3, voffA);
            PG8_BAR; PG8_WAIT_L(0); PG8_MMA(1, 0, At, B0); PG8_BAR; PG8_SCHED;
            PG8_STAGE(PG8_SB(1, 1), b3 + hstep, voffB);
            PG8_WAIT_V(6); PG8_BAR; PG8_MMA(1, 1, At, B1); PG8_BAR;
            }
        }
        if constexpr (ALIGN_EPI) { if (wr == 0) PG8_BAR; }
        if constexpr (!Epi::AFTER_DRAIN) { E(acc, cur, wr, wc, fr, fq); S.done(cur); }
        if (!has_next) break;
#pragma unroll
        for (int a = 0; a < 2; ++a)
#pragma unroll
            for (int b = 0; b < 2; ++b)
#pragma unroll
                for (int m = 0; m < 4; ++m)
#pragma unroll
                    for (int n = 0; n < 2; ++n) acc[a][b][m][n] = (f32x4){0.f, 0.f, 0.f, 0.f};
        cur = nxt; cA = nA; cB = nB; ++ui;
        if constexpr (ALIGN_EPI) { if (wr == 1) PG8_BAR; }
    }
    PG8_WAIT_V(0);
    if constexpr (!ALIGN_EPI) { if (wr == 0) PG8_BAR; }
    PG8_BAR;
    if constexpr (Epi::AFTER_DRAIN) { E.fused(acc, cur, wr, wc, fr, fq, lds, wid, lane); S.done(cur); }
#undef PG8_SA
#undef PG8_SB
#undef PG8_STAGE
#undef PG8_LDA
#undef PG8_LDB
#undef PG8_MMA
#undef PG8_WAIT_V
#undef PG8_WAIT_L
#undef PG8_BAR
#undef PG8_SCHED
}
}
using pg8::bf16_t; using pg8::bf16x8; using pg8::f32x4; using pg8::u32x4; using pg8::Unit;
typedef PG8_LAS unsigned char* LP;
typedef unsigned u32x2 __attribute__((ext_vector_type(2)));
typedef float f32x2 __attribute__((ext_vector_type(2)));
typedef float f32x16 __attribute__((ext_vector_type(16)));
typedef __bf16 bf16x2_t __attribute__((ext_vector_type(2)));
#define DI __device__ __forceinline__

constexpr int D = 2048, NB = 8, SEQ = 2048, CTXL = 256, NLAT = NB * SEQ, NCTX = NB * CTXL, MT = NLAT + NCTX;
constexpr int INW = 3072, DFF = 5632, NUP = 2 * DFF;
constexpr int NTHR = 512;
constexpr float EPS = 1e-6f;
constexpr float LOG2E = 1.4426950408889634f;
constexpr float QSCALE = 0.08838834764831845f * 1.4426950408889634f;
constexpr int LDS_BYTES = 131072 + 16;
enum { I_X = 0, I_C, I_CTX, I_CCTX, I_N1G, I_N2G, I_WADA, I_BADA, I_WIN, I_QNG, I_KNG, I_SINK, I_POOLW, I_POOLS, I_SGUNG, I_SGUW, I_SGUB, I_WOUT, I_WUP, I_CONVW, I_CONVB, I_WDOWN, I_FNG, N_IN };
constexpr size_t SZ_WIN = (size_t)INW * D * 2, SZ_WOUT = (size_t)D * D * 2, SZ_WUP = (size_t)NUP * D * 2, SZ_WDN = (size_t)D * DFF * 2;
constexpr size_t WS_WIN = 0, WS_WOUT = WS_WIN + 2 * SZ_WIN, WS_WUP = WS_WOUT + 2 * SZ_WOUT, WS_WDN = WS_WUP + 2 * SZ_WUP;
constexpr size_t WS_BAR = WS_WDN + 2 * SZ_WDN;
constexpr size_t WS_MOD = WS_BAR + 16384;
constexpr size_t WS_ROPE = WS_MOD + (size_t)2 * 9 * 6 * D * 4;
constexpr size_t WS_H = WS_ROPE + 64 * 32 * 2 * 4;
constexpr size_t WS_X = WS_H + (size_t)MT * D * 2;
constexpr size_t WS_HB = WS_X + (size_t)MT * D * 4;
constexpr size_t WS_R1 = WS_HB + (size_t)144 * 4 * NUP * 4;
constexpr size_t WS_P = WS_R1;
constexpr size_t WS_MIX = WS_P + (size_t)MT * INW * 2;
constexpr size_t WS_VTL = WS_MIX + (size_t)MT * D * 2;
constexpr size_t WS_VTC = WS_VTL + (size_t)NB * 2 * 128 * SEQ * 2;
constexpr size_t WS_R1_END_A = WS_VTC + (size_t)NB * 2 * 128 * CTXL * 2;
constexpr size_t WS_ACT = WS_R1;
constexpr size_t WS_R1_END_B = WS_ACT + (size_t)MT * DFF * 2;
constexpr size_t WS_XP = WS_R1_END_A > WS_R1_END_B ? WS_R1_END_A : WS_R1_END_B;
constexpr size_t WS_KVP = WS_XP + (size_t)64 * 3 * 65536 * 4;
constexpr size_t WS_SSQ = WS_KVP + (size_t)4 * NCTX * 512 * 4;
constexpr size_t WS_END = WS_SSQ + (size_t)MT * 4;

struct Params { const float* in[N_IN]; float* out; unsigned char* ws; int ph_lo, ph_hi; };
typedef const __attribute__((address_space(4))) Params* CP;

DI int tid_l() { int t = threadIdx.x; asm volatile("" : "+v"(t)); return t; }
DI int bid_l() { int b = blockIdx.x; asm volatile("" : "+s"(b)); return b; }
DI unsigned pk2(float a, float b) { f32x2 v = {a, b}; bf16x2_t r = __builtin_convertvector(v, bf16x2_t); return __builtin_bit_cast(unsigned, r); }
DI float bf_lo(unsigned w) { return __uint_as_float(w << 16); }
DI float bf_hi(unsigned w) { return __uint_as_float(w & 0xffff0000u); }
DI float silu_f(float x) { return x * __builtin_amdgcn_rcpf(1.0f + __builtin_amdgcn_exp2f(-x * LOG2E)); }
DI float gelu_f(float x) { f32x2 v = {x, x}; return pg8::gelu_pk(v).x; }
DI f32x4 gelu4(f32x4 x) { f32x2 a = pg8::gelu_pk((f32x2){x[0], x[1]}), b = pg8::gelu_pk((f32x2){x[2], x[3]}); return (f32x4){a.x, a.y, b.x, b.y}; }

struct EpiP {
    static constexpr bool PERM = true, AFTER_DRAIN = false, ROWPERM = false;
    float* ssq;
    bf16_t* O; int ldc, row_off, col_off, gelu_from_pn;
    DI void operator()(const f32x4 (&acc)[2][2][4][2], const Unit& u, int wr, int wc, int fr, int fq) const {
        const int row0 = row_off + u.pm * 256 + wr * 64 + fr, col0 = col_off + u.pn * 256 + wc * 32 + 8 * fq;
        const bool gsq = (u.pn >= 10) && (gelu_from_pn < 12);
#pragma unroll
        for (int ai = 0; ai < 2; ++ai)
#pragma unroll
            for (int m = 0; m < 4; ++m) { bf16_t* rowp = O + (size_t)(row0 + ai * 128 + m * 16) * ldc + col0; float s = 0.f;
#pragma unroll
                for (int bj = 0; bj < 2; ++bj) { f32x4 v0 = acc[ai][bj][m][0], v1 = acc[ai][bj][m][1];
                    if (u.pn >= gelu_from_pn) { v0 = gelu4(v0); v1 = gelu4(v1); }
                    s += v0[0] * v0[0] + v0[1] * v0[1] + v0[2] * v0[2] + v0[3] * v0[3] + v1[0] * v1[0] + v1[1] * v1[1] + v1[2] * v1[2] + v1[3] * v1[3];
                    u32x4 w; w.x = pk2(v0[0], v0[1]); w.y = pk2(v0[2], v0[3]); w.z = pk2(v1[0], v1[1]); w.w = pk2(v1[2], v1[3]);
                    *(u32x4*)(rowp + bj * 128) = w; }
                if (gsq) { s += __shfl_xor(s, 16); s += __shfl_xor(s, 32); if (fq == 0) atomicAdd(ssq + row0 + ai * 128 + m * 16, s); } }
    }
};
struct EpiKVPart {
    static constexpr bool PERM = false, AFTER_DRAIN = false, ROWPERM = false;
    float* kvp;
    DI void operator()(const f32x4 (&acc)[2][2][4][2], const Unit& u, int wr, int wc, int fr, int fq) const {
        float* op = kvp + ((size_t)u.part * NCTX + u.pm * 256 + wr * 64 + fr) * 512 + u.pn * 256 + wc * 32 + 4 * fq;
#pragma unroll
        for (int ai = 0; ai < 2; ++ai)
#pragma unroll
            for (int m = 0; m < 4; ++m)
#pragma unroll
                for (int bj = 0; bj < 2; ++bj)
#pragma unroll
                    for (int n = 0; n < 2; ++n) *(f32x4*)(op + (size_t)(ai * 128 + m * 16) * 512 + bj * 128 + n * 16) = acc[ai][bj][m][n];
    }
};
struct EpiRes {
    static constexpr bool PERM = false, AFTER_DRAIN = false, ROWPERM = false;
    const float* base_lat; const float* base_ctx; float* out; float* xpart; const float* gate;
    DI void operator()(const f32x4 (&acc)[2][2][4][2], const Unit& u, int wr, int wc, int fr, int fq) const {
        const int row0 = u.pm * 256 + wr * 64 + fr, col0 = u.pn * 256 + wc * 32 + 4 * fq;
        const int b = u.pm < 64 ? (u.pm >> 3) : 8;
        const float* gp = gate + (size_t)b * 6 * D + col0;
        f32x4 gv[2][2];
#pragma unroll
        for (int bj = 0; bj < 2; ++bj)
#pragma unroll
            for (int n = 0; n < 2; ++n) gv[bj][n] = *(const f32x4*)(gp + bj * 128 + n * 16);
        if (u.part != 0) {
            float* xp = xpart + ((size_t)(u.tidx * 3 + u.part - 1) << 16) + (size_t)(wr * 64 + fr) * 256 + wc * 32 + 4 * fq;
#pragma unroll
            for (int ai = 0; ai < 2; ++ai)
#pragma unroll
                for (int m = 0; m < 4; ++m)
#pragma unroll
                    for (int bj = 0; bj < 2; ++bj)
#pragma unroll
                        for (int n = 0; n < 2; ++n) *(f32x4*)(xp + (size_t)(ai * 128 + m * 16) * 256 + bj * 128 + n * 16) = gv[bj][n] * acc[ai][bj][m][n];
            return;
        }
        const float* bp = (u.pm < 64 ? base_lat + (size_t)row0 * D : base_ctx + (size_t)(row0 - NLAT) * D) + col0;
        float* op = out + (size_t)row0 * D + col0;
        f32x4 bs[4], bn[4];
#pragma unroll
        for (int q = 0; q < 4; ++q) bs[q] = *(const f32x4*)(bp + (q >> 1) * 128 + (q & 1) * 16);
#pragma unroll
        for (int g = 0; g < 8; ++g) { const int ai = g >> 2, m = g & 3; const size_t off = (size_t)(ai * 128 + m * 16) * D;
            if (g < 7) { const size_t offn = (size_t)(((g + 1) >> 2) * 128 + ((g + 1) & 3) * 16) * D;
#pragma unroll
                for (int q = 0; q < 4; ++q) bn[q] = *(const f32x4*)(bp + offn + (q >> 1) * 128 + (q & 1) * 16); }
#pragma unroll
            for (int q = 0; q < 4; ++q) { const int bj = q >> 1, n = q & 1; *(f32x4*)(op + off + bj * 128 + n * 16) = bs[q] + gv[bj][n] * acc[ai][bj][m][n]; }
            asm volatile("" ::: "memory");
#pragma unroll
            for (int q = 0; q < 4; ++q) bs[q] = bn[q]; }
    }
};
struct EpiConvGlu {
    static constexpr bool PERM = true, AFTER_DRAIN = false, ROWPERM = true;
    bf16_t* act; float* hb; const float* cw; const float* cb;
    DI void operator()(const f32x4 (&acc)[2][2][4][2], const Unit& u, int wr, int wc, int fr, int fq) const {
        const int tok0 = u.pm * 256 + 128 * wr + 8 * fr, cl0 = wc * 32 + 8 * fq;
#pragma unroll
        for (int n = 0; n < 2; ++n) {
            const int cl = cl0 + 4 * n, chg = u.pn * 128 + cl, chv = DFF + chg;
            const f32x4 w0g = *(const f32x4*)(cw + chg), w1g = *(const f32x4*)(cw + NUP + chg), w2g = *(const f32x4*)(cw + 2 * NUP + chg), bg = *(const f32x4*)(cb + chg);
            const f32x4 w0v = *(const f32x4*)(cw + chv), w1v = *(const f32x4*)(cw + NUP + chv), w2v = *(const f32x4*)(cw + 2 * NUP + chv), bv = *(const f32x4*)(cb + chv);
            f32x4 gp, gn, vp, vn;
#pragma unroll
            for (int e = 0; e < 4; ++e) {
                gp[e] = __int_as_float(__builtin_amdgcn_update_dpp(0, __float_as_int(acc[1][0][3][n][e]), 0x111, 0xf, 0xf, true)); gn[e] = __int_as_float(__builtin_amdgcn_update_dpp(0, __float_as_int(acc[0][0][0][n][e]), 0x101, 0xf, 0xf, true));
                vp[e] = __int_as_float(__builtin_amdgcn_update_dpp(0, __float_as_int(acc[1][1][3][n][e]), 0x111, 0xf, 0xf, true)); vn[e] = __int_as_float(__builtin_amdgcn_update_dpp(0, __float_as_int(acc[0][1][0][n][e]), 0x101, 0xf, 0xf, true)); }
            if (fr == 0) { gp = (f32x4){0.f, 0.f, 0.f, 0.f}; vp = gp; }
            if (fr == 15) { gn = (f32x4){0.f, 0.f, 0.f, 0.f}; vn = gn; }
            if (fr == 0 || fr == 15) {
                float* hp = hb + ((size_t)(u.pm * 2 + wr) * 4 + (fr ? 2 : 0)) * NUP + u.pn * 256 + cl;
                const int j0 = fr ? 6 : 0;
                const f32x4 g0 = fr ? acc[1][0][2][n] : acc[0][0][0][n], g1 = fr ? acc[1][0][3][n] : acc[0][0][1][n];
                const f32x4 v0 = fr ? acc[1][1][2][n] : acc[0][1][0][n], v1 = fr ? acc[1][1][3][n] : acc[0][1][1][n];
                (void)j0;
                *(f32x4*)(hp) = g0; *(f32x4*)(hp + 128) = v0; *(f32x4*)(hp + NUP) = g1; *(f32x4*)(hp + NUP + 128) = v1;
            }
#pragma unroll
            for (int j = 0; j < 8; ++j) {
                const f32x4 gP = j ? acc[(j - 1) >> 2][0][(j - 1) & 3][n] : gp, gC = acc[j >> 2][0][j & 3][n], gN = j < 7 ? acc[(j + 1) >> 2][0][(j + 1) & 3][n] : gn;
                const f32x4 vP = j ? acc[(j - 1) >> 2][1][(j - 1) & 3][n] : vp, vC = acc[j >> 2][1][j & 3][n], vN = j < 7 ? acc[(j + 1) >> 2][1][(j + 1) & 3][n] : vn;
                const f32x4 cg_ = bg + w0g * gP + w1g * gC + w2g * gN, cv_ = bv + w0v * vP + w1v * vC + w2v * vN;
                f32x4 o;
#pragma unroll
                for (int e = 0; e < 4; ++e) o[e] = silu_f(cg_[e]) * cv_[e];
                u32x2 w; w.x = pk2(o[0], o[1]); w.y = pk2(o[2], o[3]);
                *(u32x2*)(act + (size_t)(tok0 + j) * DFF + u.pn * 128 + cl) = w;
            }
            asm volatile("" ::: "memory");
        }
    }
};
#include <cstdlib>
#include <vector>

#define XB_TMO      128
#define XB_XCNT(j)  (256  + 64 * (j))
#define XB_XSUB(j)  (1280 + 64 * (j))
#define XB_XGEN(j)  (2304 + 64 * (j))
#define XB_TOP      3328
#define XB_TOPGEN   3392
#define XCD_BAR_WORDS 3456
#define XB_SPIN_CAP (1u << 18)

__device__ __forceinline__ unsigned xb_ld(unsigned* p)              { return __hip_atomic_load(p, __ATOMIC_RELAXED, __HIP_MEMORY_SCOPE_AGENT); }
__device__ __forceinline__ unsigned xb_add(unsigned* p, unsigned v) { return __hip_atomic_fetch_add(p, v, __ATOMIC_RELAXED, __HIP_MEMORY_SCOPE_AGENT); }
__device__ __forceinline__ unsigned xb_xcc_id() { return (unsigned)__builtin_amdgcn_s_getreg((3 << 11) | 20) & 0xFu; }
#define XB_SPIN(cond, bar) do { unsigned _sp = 0; while (cond) { __builtin_amdgcn_s_sleep(1); \
    if ((++_sp & 255u) == 0u) { if (xb_ld(&(bar)[XB_TMO])) break; if (_sp > XB_SPIN_CAP) { atomicAdd(&(bar)[XB_TMO], 1u); break; } } } } while (0)

struct XcdBarrier {
    unsigned* bar; unsigned x;
    volatile PG8_LAS unsigned* st;
};

__device__ __forceinline__ XcdBarrier xcd_barrier_post(unsigned* bar, volatile PG8_LAS unsigned* st) {
    XcdBarrier b; b.bar = bar; b.x = xb_xcc_id(); b.st = st;
    if (threadIdx.x == 0) (void)xb_add(&bar[XB_XCNT(b.x)], 1u);
    return b;
}
__device__ __forceinline__ void xcd_barrier_complete(unsigned* bar, unsigned x, unsigned& nloc, unsigned& nx) {
    const unsigned G = gridDim.x * gridDim.y * gridDim.z;
    unsigned sum, cnt, mine, sp = 0u;
    for (;;) {
        sum = 0u; cnt = 0u; mine = 0u;
#pragma unroll
        for (unsigned j = 0; j < 16; ++j) { const unsigned c = xb_ld(&bar[XB_XCNT(j)]); sum += c; cnt += (c > 0u) ? 1u : 0u; mine = (j == x) ? c : mine; }
        if (sum == G) break;
        __builtin_amdgcn_s_sleep(1);
        if ((++sp & 255u) == 0u) { if (xb_ld(&bar[XB_TMO])) break; if (sp > XB_SPIN_CAP) { atomicAdd(&bar[XB_TMO], 1u); break; } }
    }
    nloc = mine > 0u ? mine : 1u; nx = cnt > 0u ? cnt : 1u;
}

__device__ __forceinline__ void xcd_barrier(const XcdBarrier& b) {
    asm volatile("s_waitcnt vmcnt(0)" ::: "memory");
    __syncthreads();
    if (threadIdx.x == 0) {
        unsigned* bar = b.bar;
        __builtin_amdgcn_s_waitcnt(0);
        unsigned nloc = b.st[0], nx = b.st[1];
        if (nloc == 0u) { xcd_barrier_complete(bar, b.x, nloc, nx); b.st[0] = nloc; b.st[1] = nx; }
        const unsigned old = xb_add(&bar[XB_XSUB(b.x)], 1u);
        const unsigned gen = old / nloc;
        if (old + 1u == (gen + 1u) * nloc) {
            __builtin_amdgcn_fence(__ATOMIC_RELEASE, "agent");
            asm volatile("s_waitcnt vmcnt(0)" ::: "memory");
            const unsigned og = xb_add(&bar[XB_TOP], 1u);
            const unsigned tg = og / nx;
            if (og + 1u == (tg + 1u) * nx) xb_add(&bar[XB_TOPGEN], 1u);
            else XB_SPIN(xb_ld(&bar[XB_TOPGEN]) == tg, bar);
            __builtin_amdgcn_fence(__ATOMIC_ACQUIRE, "agent");
            xb_add(&bar[XB_XGEN(b.x)], 1u);
            asm volatile("s_waitcnt vmcnt(0)" ::: "memory");
        } else {
            XB_SPIN(xb_ld(&bar[XB_XGEN(b.x)]) == gen, bar);
            __builtin_amdgcn_fence(__ATOMIC_ACQUIRE, "agent");
            asm volatile("s_waitcnt vmcnt(0)" ::: "memory");
        }
    }
    __syncthreads();
}
DI void conv_tile(const float* __restrict__ W, int N, int k0, int srcc0, bf16_t* __restrict__ Wt, int K, int dstn0, LP lds, int tid) {
    PG8_LAS float* tile = (PG8_LAS float*)lds;
#pragma unroll
    for (int i = 0; i < 4; ++i) { const int k = (tid >> 4) + 32 * i, n4 = (tid & 15) * 4;
        const f32x4 v = *(const f32x4*)(W + (size_t)(k0 + k) * N + srcc0 + n4);
        tile[k * 65 + n4 + 0] = v[0]; tile[k * 65 + n4 + 1] = v[1]; tile[k * 65 + n4 + 2] = v[2]; tile[k * 65 + n4 + 3] = v[3]; }
    __syncthreads();
    const int n = tid >> 3, ks = (tid & 7) * 16;
    u32x4 o0, o1;
    o0.x = pk2(tile[(ks + 0) * 65 + n], tile[(ks + 1) * 65 + n]); o0.y = pk2(tile[(ks + 2) * 65 + n], tile[(ks + 3) * 65 + n]);
    o0.z = pk2(tile[(ks + 4) * 65 + n], tile[(ks + 5) * 65 + n]); o0.w = pk2(tile[(ks + 6) * 65 + n], tile[(ks + 7) * 65 + n]);
    o1.x = pk2(tile[(ks + 8) * 65 + n], tile[(ks + 9) * 65 + n]); o1.y = pk2(tile[(ks + 10) * 65 + n], tile[(ks + 11) * 65 + n]);
    o1.z = pk2(tile[(ks + 12) * 65 + n], tile[(ks + 13) * 65 + n]); o1.w = pk2(tile[(ks + 14) * 65 + n], tile[(ks + 15) * 65 + n]);
    bf16_t* dp = Wt + (size_t)(dstn0 + n) * K + k0 + ks;
    *(u32x4*)dp = o0; *(u32x4*)(dp + 8) = o1;
    __syncthreads();
}
DI void adaln_item(CP P, int item, LP lds) {
    const int tid = tid_l(); unsigned char* ws = P->ws;
    const int l = item / 96, n0 = (item % 96) * 128;
    PG8_LAS float* s = (PG8_LAS float*)lds;
    { float cv_[36];
#pragma unroll
      for (int q = 0; q < 36; ++q) { const int i = tid + q * NTHR, b = i >> 11, k = i & 2047; cv_[q] = b < 8 ? P->in[I_C][b * D + k] : P->in[I_CCTX][k]; }
#pragma unroll
      for (int q = 0; q < 36; ++q) s[tid + q * NTHR] = silu_f(cv_[q]); }
    __syncthreads();
    const int kg = tid >> 5, cq = tid & 31;
    float acc[9][4];
#pragma unroll
    for (int b = 0; b < 9; ++b)
#pragma unroll
        for (int e = 0; e < 4; ++e) acc[b][e] = 0.f;
    const float* W = P->in[I_WADA] + (size_t)l * D * 6 * D + n0 + 4 * cq;
#pragma unroll 2
    for (int kk = 0; kk < 128; kk += 4) { const int k = kg * 128 + kk;
        f32x4 w[4];
#pragma unroll
        for (int j = 0; j < 4; ++j) w[j] = __builtin_nontemporal_load((const f32x4*)(W + (size_t)(k + j) * 6 * D));
#pragma unroll
        for (int b = 0; b < 9; ++b) { const f32x4 sv = *(const PG8_LAS f32x4*)(s + b * D + k);
#pragma unroll
            for (int j = 0; j < 4; ++j)
#pragma unroll
                for (int e = 0; e < 4; ++e) acc[b][e] += sv[j] * w[j][e]; } }
    __syncthreads();
    PG8_LAS float* red = (PG8_LAS float*)lds;
#pragma unroll
    for (int b = 0; b < 9; ++b)
#pragma unroll
        for (int e = 0; e < 4; ++e) red[(kg * 9 + b) * 128 + 4 * cq + e] = acc[b][e];
    __syncthreads();
    float* mod = (float*)(ws + WS_MOD);
    for (int o = tid; o < 9 * 128; o += NTHR) { const int b = o >> 7, ci = o & 127; float sum = P->in[I_BADA][l * 6 * D + n0 + ci];
        for (int g = 0; g < 16; ++g) sum += red[(g * 9 + b) * 128 + ci];
        mod[((size_t)l * 9 + b) * 6 * D + n0 + ci] = sum; }
    __syncthreads();
}
struct TileDesc { const float* src; bf16_t* dst; int srcN, dstK; };
DI TileDesc tile_desc(CP P, int T) {
    unsigned char* ws = P->ws; TileDesc d;
    const int l = T / 5504; int t = T % 5504;
    if (t < 768) { const int kt = t / 48, nt = t % 48; d.srcN = INW; d.dstK = D; d.src = P->in[I_WIN] + (size_t)l * D * INW + (size_t)(kt * 128) * INW + nt * 64; d.dst = (bf16_t*)(ws + WS_WIN + l * SZ_WIN) + (size_t)(nt * 64) * D + kt * 128; return d; }
    t -= 768;
    if (t < 512) { const int kt = t / 32, nt = t % 32; d.srcN = D; d.dstK = D; d.src = P->in[I_WOUT] + (size_t)l * D * D + (size_t)(kt * 128) * D + nt * 64; d.dst = (bf16_t*)(ws + WS_WOUT + l * SZ_WOUT) + (size_t)(nt * 64) * D + kt * 128; return d; }
    t -= 512;
    if (t < 2816) { const int kt = t / 176, nt = t % 176; const int np = nt * 64, pn = np >> 8, rem = np & 255; const int srcc = rem < 128 ? 128 * pn + rem : DFF + 128 * pn + rem - 128;
        d.srcN = NUP; d.dstK = D; d.src = P->in[I_WUP] + (size_t)l * D * NUP + (size_t)(kt * 128) * NUP + srcc; d.dst = (bf16_t*)(ws + WS_WUP + l * SZ_WUP) + (size_t)np * D + kt * 128; return d; }
    t -= 2816;
    { const int kt = t / 32, nt = t % 32; d.srcN = D; d.dstK = DFF; d.src = P->in[I_WDOWN] + (size_t)l * DFF * D + (size_t)(kt * 128) * D + nt * 64; d.dst = (bf16_t*)(ws + WS_WDN + l * SZ_WDN) + (size_t)(nt * 64) * DFF + kt * 128; return d; }
}
constexpr int FILL_PER = 12, FILL_TILES = 2 * 160 * FILL_PER;
DI int prep_tile_index(int bid, int G, int k) {
    if (G != 256) { const int T = bid + G * k; return T < 11008 ? T : -1; }
    if (bid >= 192) { if (k < 10) return (bid - 192) + 64 * k; k -= 10; }
    const int T = 640 + bid + 256 * k; return T < 5248 ? T : -1;
}
DI void convert_tiles_lin(CP P, LP lds, int Tbase, int stride, int count) {
    const int tid = tid_l();
    PG8_LAS float* tile = (PG8_LAS float*)lds;
    const int lk = tid >> 4, ln4 = (tid & 15) * 4, on = tid >> 3, oks = (tid & 7) * 16;
    f32x4 c0[4], c1[4]; TileDesc d0, d1;
    if (count > 0) { d0 = tile_desc(P, Tbase);
#pragma unroll
        for (int i = 0; i < 4; ++i) c0[i] = *(const f32x4*)(d0.src + (size_t)(lk + 32 * i) * d0.srcN + ln4); }
    if (count > 1) { d1 = tile_desc(P, Tbase + stride);
#pragma unroll
        for (int i = 0; i < 4; ++i) c1[i] = *(const f32x4*)(d1.src + (size_t)(lk + 32 * i) * d1.srcN + ln4); }
    for (int k = 0; k < count; ++k) {
        f32x4 c2[4]; TileDesc d2;
        if (k + 2 < count) { d2 = tile_desc(P, Tbase + (k + 2) * stride);
#pragma unroll
            for (int i = 0; i < 4; ++i) c2[i] = *(const f32x4*)(d2.src + (size_t)(lk + 32 * i) * d2.srcN + ln4); }
#pragma unroll
        for (int i = 0; i < 4; ++i) { const int kk = lk + 32 * i; tile[kk * 65 + ln4 + 0] = c0[i][0]; tile[kk * 65 + ln4 + 1] = c0[i][1]; tile[kk * 65 + ln4 + 2] = c0[i][2]; tile[kk * 65 + ln4 + 3] = c0[i][3]; }
        __syncthreads();
        u32x4 o0, o1;
        o0.x = pk2(tile[(oks + 0) * 65 + on], tile[(oks + 1) * 65 + on]); o0.y = pk2(tile[(oks + 2) * 65 + on], tile[(oks + 3) * 65 + on]);
        o0.z = pk2(tile[(oks + 4) * 65 + on], tile[(oks + 5) * 65 + on]); o0.w = pk2(tile[(oks + 6) * 65 + on], tile[(oks + 7) * 65 + on]);
        o1.x = pk2(tile[(oks + 8) * 65 + on], tile[(oks + 9) * 65 + on]); o1.y = pk2(tile[(oks + 10) * 65 + on], tile[(oks + 11) * 65 + on]);
        o1.z = pk2(tile[(oks + 12) * 65 + on], tile[(oks + 13) * 65 + on]); o1.w = pk2(tile[(oks + 14) * 65 + on], tile[(oks + 15) * 65 + on]);
        bf16_t* dp = d0.dst + (size_t)on * d0.dstK + oks;
        *(u32x4*)dp = o0; *(u32x4*)(dp + 8) = o1;
        __syncthreads();
        d0 = d1; d1 = d2;
#pragma unroll
        for (int i = 0; i < 4; ++i) { c0[i] = c1[i]; c1[i] = c2[i]; }
    }
}
DI void filler_phase(CP P, int slot, LP lds) {
    const int bid = bid_l();
    if (gridDim.x != 256) return;
    if (slot < 2) { if (bid >= 96) convert_tiles_lin(P, lds, 6016 + slot * 1920 + (bid - 96), 160, 12); }
    else if (slot == 2) { if (bid >= 64) convert_tiles_lin(P, lds, 5248 + (bid - 64), 192, 4); }
    else { if (bid >= 64) convert_tiles_lin(P, lds, 9856 + (bid - 64), 192, 6); }
}
DI void prep_phase(CP P, LP lds) {
    const int tid = tid_l(), bid = bid_l(), G = gridDim.x;
    for (int item = bid; item < 192; item += G) adaln_item(P, item, lds);
    if (bid == G - 1) { float* tab = (float*)(P->ws + WS_ROPE);
        for (int i = tid; i < 64 * 32; i += NTHR) { const int pos = i >> 5, f = i & 31; const float inv = 1.0f / powf(10000.0f, (float)(2 * f) / 64.0f); const float ang = (float)pos * inv;
            tab[2 * i] = cosf(ang); tab[2 * i + 1] = sinf(ang); } }
    PG8_LAS float* tile = (PG8_LAS float*)lds;
    const int lk = tid >> 4, ln4 = (tid & 15) * 4, on = tid >> 3, oks = (tid & 7) * 16;
    int T0 = prep_tile_index(bid, G, 0), T1 = T0 >= 0 ? prep_tile_index(bid, G, 1) : -1;
    f32x4 c0[4], c1[4]; TileDesc d0, d1;
    if (T0 >= 0) { d0 = tile_desc(P, T0);
#pragma unroll
        for (int i = 0; i < 4; ++i) c0[i] = *(const f32x4*)(d0.src + (size_t)(lk + 32 * i) * d0.srcN + ln4); }
    if (T1 >= 0) { d1 = tile_desc(P, T1);
#pragma unroll
        for (int i = 0; i < 4; ++i) c1[i] = *(const f32x4*)(d1.src + (size_t)(lk + 32 * i) * d1.srcN + ln4); }
    for (int k = 0; T0 >= 0; ++k) {
        const int T2 = T1 >= 0 ? prep_tile_index(bid, G, k + 2) : -1;
        f32x4 c2[4]; TileDesc d2;
        if (T2 >= 0) { d2 = tile_desc(P, T2);
#pragma unroll
            for (int i = 0; i < 4; ++i) c2[i] = *(const f32x4*)(d2.src + (size_t)(lk + 32 * i) * d2.srcN + ln4); }
#pragma unroll
        for (int i = 0; i < 4; ++i) { const int kk = lk + 32 * i; tile[kk * 65 + ln4 + 0] = c0[i][0]; tile[kk * 65 + ln4 + 1] = c0[i][1]; tile[kk * 65 + ln4 + 2] = c0[i][2]; tile[kk * 65 + ln4 + 3] = c0[i][3]; }
        __syncthreads();
        u32x4 o0, o1;
        o0.x = pk2(tile[(oks + 0) * 65 + on], tile[(oks + 1) * 65 + on]); o0.y = pk2(tile[(oks + 2) * 65 + on], tile[(oks + 3) * 65 + on]);
        o0.z = pk2(tile[(oks + 4) * 65 + on], tile[(oks + 5) * 65 + on]); o0.w = pk2(tile[(oks + 6) * 65 + on], tile[(oks + 7) * 65 + on]);
        o1.x = pk2(tile[(oks + 8) * 65 + on], tile[(oks + 9) * 65 + on]); o1.y = pk2(tile[(oks + 10) * 65 + on], tile[(oks + 11) * 65 + on]);
        o1.z = pk2(tile[(oks + 12) * 65 + on], tile[(oks + 13) * 65 + on]); o1.w = pk2(tile[(oks + 14) * 65 + on], tile[(oks + 15) * 65 + on]);
        bf16_t* dp = d0.dst + (size_t)on * d0.dstK + oks;
        *(u32x4*)dp = o0; *(u32x4*)(dp + 8) = o1;
        __syncthreads();
        T0 = T1; T1 = T2; d0 = d1; d1 = d2;
#pragma unroll
        for (int i = 0; i < 4; ++i) { c0[i] = c1[i]; c1[i] = c2[i]; }
    }
}
DI void norm_mod_phase(CP P, int l, int which, int nrows, LP lds) {
    const int tid = tid_l(), lane = tid & 63, wave = tid >> 6, gw = bid_l() * 8 + wave, nw = gridDim.x * 8;
    unsigned char* ws = P->ws; float* X = (float*)(ws + WS_X); bf16_t* H = (bf16_t*)(ws + WS_H);
    const bool fin = (gridDim.x == 256) && ((l == 0 && which == 1) || (l == 1 && which == 0));
    PG8_LAS int* tbl = (PG8_LAS int*)lds;
    if (fin) { for (int i = tid; i < 576; i += NTHR) tbl[i] = -1;
        __syncthreads();
        if (tid < 64) { pg8::StaticOrder S; S.init(MT, D, 256, tid); Unit u; if (S.next(2, u)) tbl[u.pm * 8 + u.pn] = tid; }
        __syncthreads(); }
    const float* XPp = (const float*)(ws + WS_XP);
    const float* g = (which ? P->in[I_N2G] : P->in[I_N1G]) + l * D;
#define NM_XROW(r_) ((l == 0 && which == 0) ? ((r_) < NLAT ? P->in[I_X] + (size_t)(r_) * D : P->in[I_CTX] + (size_t)((r_) - NLAT) * D) : X + (size_t)(r_) * D)
    const int rpw = (nrows + nw - 1) / nw, r0 = gw * rpw, r1 = (r0 + rpw) < nrows ? (r0 + rpw) : nrows;
    f32x4 v[8], ga[8], gb[8]; int bcur = -1;
    if (r0 < r1) { const float* xr0 = NM_XROW(r0);
#pragma unroll
        for (int i = 0; i < 8; ++i) v[i] = *(const f32x4*)(xr0 + 4 * lane + 256 * i); }
    for (int r = r0; r < r1; ++r) {
        const int rn = r + 1; f32x4 vn[8];
        if (rn < r1) { const float* xrn = NM_XROW(rn);
#pragma unroll
            for (int i = 0; i < 8; ++i) vn[i] = *(const f32x4*)(xrn + 4 * lane + 256 * i); }
        const int b = r < NLAT ? (r >> 11) : 8;
        if (b != bcur) { bcur = b;
            const float* sh = (const float*)(ws + WS_MOD) + (((size_t)l * 9 + b) * 6 + (which ? 3 : 0)) * D; const float* sc = sh + D;
#pragma unroll
            for (int i = 0; i < 8; ++i) { const int col = 4 * lane + 256 * i; ga[i] = *(const f32x4*)(g + col) * (1.0f + *(const f32x4*)(sc + col)); gb[i] = *(const f32x4*)(sh + col); } }
        float ss = 0.f;
#pragma unroll
        for (int i = 0; i < 8; ++i) {
            if (fin) { const int t = tbl[(r >> 8) * 8 + i];
                if (t >= 0) { const float* xp = XPp + ((size_t)(t * 3) << 16) + (size_t)(r & 255) * 256 + 4 * lane;
                    v[i] += *(const f32x4*)xp + *(const f32x4*)(xp + 65536) + *(const f32x4*)(xp + 131072);
                    *(f32x4*)(X + (size_t)r * D + 4 * lane + 256 * i) = v[i]; } }
            ss += v[i][0] * v[i][0] + v[i][1] * v[i][1] + v[i][2] * v[i][2] + v[i][3] * v[i][3]; }
#pragma unroll
        for (int o = 32; o >= 1; o >>= 1) ss += __shfl_xor(ss, o);
        const float rstd = rsqrtf(ss * (1.0f / D) + EPS);
        if (which == 0 && lane == 0) ((float*)(ws + WS_SSQ))[r] = 0.f;
#pragma unroll
        for (int i = 0; i < 8; ++i) { const int col = 4 * lane + 256 * i;
            const f32x4 h = v[i] * rstd * ga[i] + gb[i]; u32x2 w; w.x = pk2(h[0], h[1]); w.y = pk2(h[2], h[3]);
            *(u32x2*)(H + (size_t)r * D + col) = w; }
#pragma unroll
        for (int i = 0; i < 8; ++i) v[i] = vn[i];
    }
#undef NM_XROW
}
DI void final_norm_phase(CP P) {
    const int tid = tid_l(), lane = tid & 63, wave = tid >> 6, gw = bid_l() * 8 + wave, nw = gridDim.x * 8;
    const float* X = (const float*)(P->ws + WS_X); const float* g = P->in[I_FNG];
    const int rpw = (NLAT + nw - 1) / nw, r0 = gw * rpw, r1 = (r0 + rpw) < NLAT ? (r0 + rpw) : NLAT;
    f32x4 v[8], gg[8];
#pragma unroll
    for (int i = 0; i < 8; ++i) gg[i] = *(const f32x4*)(g + 4 * lane + 256 * i);
    if (r0 < r1) {
#pragma unroll
        for (int i = 0; i < 8; ++i) v[i] = *(const f32x4*)(X + (size_t)r0 * D + 4 * lane + 256 * i); }
    for (int r = r0; r < r1; ++r) {
        const int rn = r + 1; f32x4 vn[8];
        if (rn < r1) {
#pragma unroll
            for (int i = 0; i < 8; ++i) vn[i] = *(const f32x4*)(X + (size_t)rn * D + 4 * lane + 256 * i); }
        float ss = 0.f;
#pragma unroll
        for (int i = 0; i < 8; ++i) ss += v[i][0] * v[i][0] + v[i][1] * v[i][1] + v[i][2] * v[i][2] + v[i][3] * v[i][3];
#pragma unroll
        for (int o = 32; o >= 1; o >>= 1) ss += __shfl_xor(ss, o);
        const float rstd = rsqrtf(ss * (1.0f / D) + EPS);
#pragma unroll
        for (int i = 0; i < 8; ++i) *(f32x4*)(P->out + (size_t)r * D + 4 * lane + 256 * i) = v[i] * rstd * gg[i];
#pragma unroll
        for (int i = 0; i < 8; ++i) v[i] = vn[i];
    }
}
DI void qk_phase(CP P, int l) {
    const int tid = tid_l(), lane = tid & 63, wave = tid >> 6, j = lane & 15, grp = lane >> 4;
    unsigned char* ws = P->ws; bf16_t* Pb = (bf16_t*)(ws + WS_P); const float* tab = (const float*)(ws + WS_ROPE);
    const int nrows = MT, nw = gridDim.x * 8;
    float qg[8], kg[8];
#pragma unroll
    for (int e = 0; e < 8; ++e) { qg[e] = P->in[I_QNG][l * 128 + 8 * j + e] * QSCALE; kg[e] = P->in[I_KNG][l * 128 + 8 * j + e]; }
    const bool first = (j & 4) == 0;
    for (int row = bid_l() * 8 + wave; row < nrows; row += nw) {
        const bool lat = row < NLAT; const bool qrow = lat || l == 0;
        float cs[8], sn[8];
        if (lat) { const int t = row & 2047, pos = (j & 8) ? (t & 63) : (t >> 6); const float* tp = tab + (size_t)(pos * 32 + 8 * (j & 3)) * 2;
            const f32x4 t0 = *(const f32x4*)tp, t1 = *(const f32x4*)(tp + 4), t2 = *(const f32x4*)(tp + 8), t3 = *(const f32x4*)(tp + 12);
            cs[0] = t0[0]; sn[0] = t0[1]; cs[1] = t0[2]; sn[1] = t0[3]; cs[2] = t1[0]; sn[2] = t1[1]; cs[3] = t1[2]; sn[3] = t1[3];
            cs[4] = t2[0]; sn[4] = t2[1]; cs[5] = t2[2]; sn[5] = t2[3]; cs[6] = t3[0]; sn[6] = t3[1]; cs[7] = t3[2]; sn[7] = t3[3]; }
        else {
#pragma unroll
            for (int e = 0; e < 8; ++e) { cs[e] = 1.f; sn[e] = 0.f; } }
        bf16_t* rp = Pb + (size_t)row * INW + 8 * j;
        u32x4 raw[3]; const bool kact = grp < 2;
        if (qrow) { raw[0] = *(const u32x4*)(rp + grp * 128); raw[1] = *(const u32x4*)(rp + (4 + grp) * 128); }
        const bool kpart = (l == 1 && !lat);
        float kx[8];
        if (kpart) { if (kact) { const float* kp = (const float*)(ws + WS_KVP) + (size_t)(row - NLAT) * 512 + grp * 128 + 8 * j;
                f32x4 a0 = *(const f32x4*)kp, a1 = *(const f32x4*)(kp + 4);
#pragma unroll
                for (int q = 1; q < 4; ++q) { a0 += *(const f32x4*)(kp + (size_t)q * NCTX * 512); a1 += *(const f32x4*)(kp + (size_t)q * NCTX * 512 + 4); }
                kx[0] = a0[0]; kx[1] = a0[1]; kx[2] = a0[2]; kx[3] = a0[3]; kx[4] = a1[0]; kx[5] = a1[1]; kx[6] = a1[2]; kx[7] = a1[3]; }
            else {
#pragma unroll
                for (int e = 0; e < 8; ++e) kx[e] = 0.f; } }
        else raw[2] = *(const u32x4*)(rp + 1024 + (kact ? grp : 0) * 128);
#pragma unroll
        for (int pass = 0; pass < 3; ++pass) {
            if (pass < 2 && !qrow) continue;
            float x[8];
            if (pass == 2 && kpart) {
#pragma unroll
                for (int e = 0; e < 8; ++e) x[e] = kx[e]; }
            else { const u32x4 rw = raw[pass]; x[0] = bf_lo(rw.x); x[1] = bf_hi(rw.x); x[2] = bf_lo(rw.y); x[3] = bf_hi(rw.y); x[4] = bf_lo(rw.z); x[5] = bf_hi(rw.z); x[6] = bf_lo(rw.w); x[7] = bf_hi(rw.w); }
            float ss = 0.f;
#pragma unroll
            for (int e = 0; e < 8; ++e) ss += x[e] * x[e];
            ss += __shfl_xor(ss, 1); ss += __shfl_xor(ss, 2); ss += __shfl_xor(ss, 4); ss += __shfl_xor(ss, 8);
            const float rstd = rsqrtf(ss * (1.0f / 128.0f) + EPS);
            float y[8], yp[8];
#pragma unroll
            for (int e = 0; e < 8; ++e) y[e] = x[e] * rstd * (pass < 2 ? qg[e] : kg[e]);
#pragma unroll
            for (int e = 0; e < 8; ++e) yp[e] = __shfl_xor(y[e], 4);
#pragma unroll
            for (int e = 0; e < 8; ++e) y[e] = first ? (y[e] * cs[e] - yp[e] * sn[e]) : (y[e] * cs[e] + yp[e] * sn[e]);
            u32x4 w; w.x = pk2(y[0], y[1]); w.y = pk2(y[2], y[3]); w.z = pk2(y[4], y[5]); w.w = pk2(y[6], y[7]);
            if (pass == 0) *(u32x4*)(rp + grp * 128) = w;
            else if (pass == 1) *(u32x4*)(rp + (4 + grp) * 128) = w;
            else if (kact) *(u32x4*)(rp + 1024 + grp * 128) = w;
        }
    }
}
DI void vt_phase(CP P, int l, LP lds) {
    const int tid = tid_l(); unsigned char* ws = P->ws; const bf16_t* Pb = (const bf16_t*)(ws + WS_P);
    for (int it = bid_l(); it < 288; it += gridDim.x) {
        int rowbase, LV, t0, b; bf16_t* dst;
        if (it < 256) { b = it >> 5; t0 = (it & 31) * 64; rowbase = b * SEQ + t0; LV = SEQ; dst = (bf16_t*)(ws + WS_VTL) + (size_t)b * 2 * 128 * SEQ + t0; }
        else { const int i2 = it - 256; b = i2 >> 2; t0 = (i2 & 3) * 64; rowbase = NLAT + b * CTXL + t0; LV = CTXL; dst = (bf16_t*)(ws + WS_VTC) + (size_t)b * 2 * 128 * CTXL + t0; }
#pragma unroll
        for (int i = 0; i < 4; ++i) { const int idx = tid + 512 * i, row = idx >> 5, c16 = idx & 31;
            u32x4 v;
            if (l == 1 && it >= 256) {
                const float* vp = (const float*)(ws + WS_KVP) + (size_t)(rowbase - NLAT + row) * 512 + 256 + 8 * c16;
                f32x4 a0 = *(const f32x4*)vp, a1 = *(const f32x4*)(vp + 4);
#pragma unroll
                for (int q = 1; q < 4; ++q) { a0 += *(const f32x4*)(vp + (size_t)q * NCTX * 512); a1 += *(const f32x4*)(vp + (size_t)q * NCTX * 512 + 4); }
                v.x = pk2(a0[0], a0[1]); v.y = pk2(a0[2], a0[3]); v.z = pk2(a1[0], a1[1]); v.w = pk2(a1[2], a1[3]);
            } else v = *(const u32x4*)(Pb + (size_t)(rowbase + row) * INW + 1280 + 8 * c16);
            *(PG8_LAS u32x4*)(lds + row * 528 + c16 * 16) = v; }
        __syncthreads();
#pragma unroll
        for (int i = 0; i < 4; ++i) { const int idx = tid + 512 * i, col = idx >> 3, ts = idx & 7;
            unsigned short e[8];
#pragma unroll
            for (int k = 0; k < 8; ++k) e[k] = *(const PG8_LAS unsigned short*)(lds + (8 * ts + k) * 528 + col * 2);
            u32x4 w; w.x = e[0] | ((unsigned)e[1] << 16); w.y = e[2] | ((unsigned)e[3] << 16); w.z = e[4] | ((unsigned)e[5] << 16); w.w = e[6] | ((unsigned)e[7] << 16);
            *(u32x4*)(dst + (size_t)col * LV + 8 * ts) = w; }
        __syncthreads();
    }
}
#define MFMA16(a, b, c) __builtin_amdgcn_mfma_f32_16x16x32_bf16((a), (b), (c), 0, 0, 0)
#define MFMA32(a, b, c) __builtin_amdgcn_mfma_f32_32x32x16_bf16((a), (b), (c), 0, 0, 0)
DI void pool_phase(CP P, int l, LP lds) {
    const int tid = tid_l(), lane = tid & 63, wave = tid >> 6; unsigned char* ws = P->ws;
    const bf16_t* Pb = (const bf16_t*)(ws + WS_P); bf16_t* MIX = (bf16_t*)(ws + WS_MIX);
    const LP raw = lds, Yl = lds + 144 * 272, Wt = lds + 144 * 272 + 128 * 272;
    const int nitems = (l == 0 ? 144 : 128) * 4; int wgi = -1;
    for (int it = bid_l(); it < nitems; it += gridDim.x) {
        const int gi = it & 3, tile = it >> 2, row0 = tile * 128;
        const int L = row0 < NLAT ? SEQ : CTXL, s0 = row0 < NLAT ? (row0 & ~(SEQ - 1)) : NLAT + ((row0 - NLAT) & ~(CTXL - 1)), tpos0 = row0 - s0;
        const int w = 2 << gi;
        { u32x4 rv_[5]; bool ok_[5];
#pragma unroll
          for (int q = 0; q < 5; ++q) { const int i = tid + q * NTHR, rr = i >> 4, c = i & 15, tp = tpos0 - 8 + rr; ok_[q] = (i < 144 * 16) && tp >= 0 && tp < L;
              if (ok_[q]) rv_[q] = *(const u32x4*)(Pb + (size_t)(s0 + tp) * INW + 1536 + gi * 128 + c * 8); }
#pragma unroll
          for (int q = 0; q < 5; ++q) { const int i = tid + q * NTHR, rr = i >> 4, c = i & 15; if (ok_[q]) *(PG8_LAS u32x4*)(raw + rr * 272 + c * 16) = rv_[q]; } }
        if (gi != wgi) { wgi = gi;
            const float* pw = P->in[I_POOLW] + ((size_t)l * 4 + gi) * 128 * 128;
            f32x4 wv_[8];
#pragma unroll
            for (int q = 0; q < 8; ++q) { const int i = tid + q * NTHR; wv_[q] = *(const f32x4*)(pw + (i >> 5) * 128 + (i & 31) * 4); }
#pragma unroll
            for (int q = 0; q < 8; ++q) { const int i = tid + q * NTHR, c = i >> 5, d4 = (i & 31) * 4;
#pragma unroll
                for (int e = 0; e < 4; ++e) *(PG8_LAS unsigned short*)(Wt + (d4 + e) * 272 + c * 2) = (unsigned short)(pk2(wv_[q][e], 0.f) & 0xffffu); } }
        __syncthreads();
        { const int t = tid >> 2, cs = (tid & 3) * 32, tp = tpos0 + t;
          int lo = tp - (w >> 1), hi = lo + w; lo = lo < 0 ? 0 : lo; hi = hi > L ? L : hi; const float inv = 1.0f / (float)(hi - lo);
#pragma unroll
          for (int q = 0; q < 4; ++q) { float sum[8];
#pragma unroll
              for (int e = 0; e < 8; ++e) sum[e] = 0.f;
              for (int tt = lo; tt < hi; ++tt) { const u32x4 v = *(const PG8_LAS u32x4*)(raw + (tt - tpos0 + 8) * 272 + (cs + 8 * q) * 2);
                  sum[0] += bf_lo(v.x); sum[1] += bf_hi(v.x); sum[2] += bf_lo(v.y); sum[3] += bf_hi(v.y); sum[4] += bf_lo(v.z); sum[5] += bf_hi(v.z); sum[6] += bf_lo(v.w); sum[7] += bf_hi(v.w); }
              const u32x4 sv = *(const PG8_LAS u32x4*)(raw + (t + 8) * 272 + (cs + 8 * q) * 2);
              u32x4 o; o.x = pk2(sum[0] * inv - bf_lo(sv.x), sum[1] * inv - bf_hi(sv.x)); o.y = pk2(sum[2] * inv - bf_lo(sv.y), sum[3] * inv - bf_hi(sv.y));
              o.z = pk2(sum[4] * inv - bf_lo(sv.z), sum[5] * inv - bf_hi(sv.z)); o.w = pk2(sum[6] * inv - bf_lo(sv.w), sum[7] * inv - bf_hi(sv.w));
              *(PG8_LAS u32x4*)(Yl + t * 272 + (cs + 8 * q) * 2) = o; } }
        __syncthreads();
        { f32x4 acc[8];
#pragma unroll
          for (int dt = 0; dt < 8; ++dt) acc[dt] = (f32x4){0.f, 0.f, 0.f, 0.f};
          const int li = lane & 15, lq = lane >> 4;
#pragma unroll
          for (int ks = 0; ks < 4; ++ks) { const bf16x8 bfr = *(const PG8_LAS bf16x8*)(Yl + (16 * wave + li) * 272 + (32 * ks + 8 * lq) * 2);
#pragma unroll
              for (int dt = 0; dt < 8; ++dt) { const bf16x8 afr = *(const PG8_LAS bf16x8*)(Wt + (16 * dt + li) * 272 + (32 * ks + 8 * lq) * 2); acc[dt] = MFMA16(afr, bfr, acc[dt]); } }
          const int token = row0 + 16 * wave + li; const float* psc = P->in[I_POOLS] + l * 512 + gi * 128 + 4 * lq;
          f32x4 sc_[8];
#pragma unroll
          for (int dt = 0; dt < 8; ++dt) sc_[dt] = *(const f32x4*)(psc + 16 * dt);
#pragma unroll
          for (int dt = 0; dt < 8; ++dt) { const f32x4 o = acc[dt] * sc_[dt]; u32x2 wv; wv.x = pk2(o[0], o[1]); wv.y = pk2(o[2], o[3]);
              *(u32x2*)(MIX + (size_t)token * D + 1024 + gi * 128 + 16 * dt + 4 * lq) = wv; } }
        __syncthreads();
    }
}
DI void sgu_phase(CP P, int l, LP lds) {
    const int tid = tid_l(), lane = tid & 63, wave = tid >> 6; unsigned char* ws = P->ws;
    const bf16_t* Pb = (const bf16_t*)(ws + WS_P); bf16_t* MIX = (bf16_t*)(ws + WS_MIX);
    const LP Vt = lds, Wl = lds + 128 * 272;
    const int nitems = (l == 0 ? 144 : 128) * 4; int whh = -1;
    for (int it = bid_l(); it < nitems; it += gridDim.x) {
        const int hh = it & 3, chunk = it >> 2, row0 = chunk * 128;
        const int q = tid >> 2, part = tid & 3;
        const bf16_t* gr = Pb + (size_t)(row0 + q) * INW + 2560;
        const float ss = ((const float*)(ws + WS_SSQ))[row0 + q];
        const float rstd = rsqrtf(ss * (1.0f / 512.0f) + EPS);
        const float* gn = P->in[I_SGUNG] + l * 512 + hh * 128 + part * 32;
#pragma unroll
        for (int i = 0; i < 4; ++i) { const u32x4 v = *(const u32x4*)(gr + hh * 128 + part * 32 + 8 * i);
            const f32x4 a = (f32x4){bf_lo(v.x), bf_hi(v.x), bf_lo(v.y), bf_hi(v.y)}, b = (f32x4){bf_lo(v.z), bf_hi(v.z), bf_lo(v.w), bf_hi(v.w)};
            const f32x4 g0 = *(const f32x4*)(gn + 8 * i), g1 = *(const f32x4*)(gn + 8 * i + 4);
            const int c0 = part * 32 + 8 * i;
#pragma unroll
            for (int e = 0; e < 4; ++e) { *(PG8_LAS unsigned short*)(Vt + (c0 + e) * 272 + q * 2) = (unsigned short)(pk2(a[e] * rstd * g0[e], 0.f) & 0xffffu);
                                          *(PG8_LAS unsigned short*)(Vt + (c0 + 4 + e) * 272 + q * 2) = (unsigned short)(pk2(b[e] * rstd * g1[e], 0.f) & 0xffffu); } }
        if (hh != whh) { whh = hh;
            const float* sw = P->in[I_SGUW] + ((size_t)l * 4 + hh) * 128 * 128;
            f32x4 wv_[8];
#pragma unroll
            for (int q = 0; q < 8; ++q) { const int i = tid + q * NTHR; wv_[q] = *(const f32x4*)(sw + (i >> 5) * 128 + (i & 31) * 4); }
#pragma unroll
            for (int q = 0; q < 8; ++q) { const int i = tid + q * NTHR, pp = i >> 5, q4 = (i & 31) * 4;
                u32x2 o; o.x = pk2(wv_[q][0], wv_[q][1]); o.y = pk2(wv_[q][2], wv_[q][3]); *(PG8_LAS u32x2*)(Wl + pp * 272 + q4 * 2) = o; } }
        __syncthreads();
        { f32x4 acc[8];
#pragma unroll
          for (int ct = 0; ct < 8; ++ct) acc[ct] = (f32x4){0.f, 0.f, 0.f, 0.f};
          const int li = lane & 15, lq = lane >> 4;
#pragma unroll
          for (int ks = 0; ks < 4; ++ks) { const bf16x8 wfr = *(const PG8_LAS bf16x8*)(Wl + (16 * wave + li) * 272 + (32 * ks + 8 * lq) * 2);
#pragma unroll
              for (int ct = 0; ct < 8; ++ct) { const bf16x8 vfr = *(const PG8_LAS bf16x8*)(Vt + (16 * ct + li) * 272 + (32 * ks + 8 * lq) * 2); acc[ct] = MFMA16(vfr, wfr, acc[ct]); } }
          const int pl = 16 * wave + li, token = row0 + pl; const float bias = P->in[I_SGUB][(l * 4 + hh) * 128 + pl];
          const bf16_t* up = Pb + (size_t)token * INW + 2048 + hh * 128 + 4 * lq;
          u32x2 uv_[8];
#pragma unroll
          for (int ct = 0; ct < 8; ++ct) uv_[ct] = *(const u32x2*)(up + 16 * ct);
#pragma unroll
          for (int ct = 0; ct < 8; ++ct) { const u32x2 uv = uv_[ct]; const f32x4 ug = (f32x4){bf_lo(uv.x), bf_hi(uv.x), bf_lo(uv.y), bf_hi(uv.y)};
              const f32x4 o = ug * (acc[ct] + bias); u32x2 wv; wv.x = pk2(o[0], o[1]); wv.y = pk2(o[2], o[3]);
              *(u32x2*)(MIX + (size_t)token * D + 1536 + hh * 128 + 16 * ct + 4 * lq) = wv; } }
        __syncthreads();
    }
}
DI void attn_phase(CP P, int l, LP lds) {
    const int tid = tid_l(), lane = tid & 63, wave = tid >> 6, r = lane & 31, h = lane >> 5; unsigned char* ws = P->ws;
    const bf16_t* Pb = (const bf16_t*)(ws + WS_P); bf16_t* MIX = (bf16_t*)(ws + WS_MIX);
    const bf16_t* VTL = (const bf16_t*)(ws + WS_VTL); const bf16_t* VTC = (const bf16_t*)(ws + WS_VTC);
    constexpr int ATT_BUF = 64 * 272 + 128 * 144;
    const LP Kl = lds, Vl = lds + 64 * 272;
    const int nitems = l == 0 ? 576 : 512;
    for (int it = bid_l(); it < nitems; it += gridDim.x) {
        const bool isctx = it >= 512; int b, n, kh, hp;
        if (!isctx) { hp = it & 1; kh = (it >> 1) & 1; n = (it >> 2) & 15; b = it >> 6; } else { const int i2 = it - 512; hp = i2 & 1; kh = (i2 >> 1) & 1; n = (i2 >> 2) & 1; b = i2 >> 3; }
        const int qrow0 = isctx ? NLAT + b * CTXL + n * 128 : b * SEQ + n * 128;
        const int hq = kh * 4 + hp * 2 + (wave >> 2), qsub = wave & 3, myrow = qrow0 + qsub * 32 + r;
        bf16x8 qf[8];
#pragma unroll
        for (int ks = 0; ks < 8; ++ks) qf[ks] = *(const bf16x8*)(Pb + (size_t)myrow * INW + hq * 128 + 16 * ks + 8 * h);
        const int kb_lo = n > 0 ? n - 1 : 0, kb_hi = n < 15 ? n + 1 : 15;
        const int nband = isctx ? 0 : (kb_hi - kb_lo + 1) * 2, nch = nband + 4;
        float m = P->in[I_SINK][l * 8 + hq] * LOG2E, lsum = 1.0f;
        f32x16 O[4];
#pragma unroll
        for (int dt = 0; dt < 4; ++dt)
#pragma unroll
            for (int i = 0; i < 16; ++i) O[dt][i] = 0.f;
        u32x4 pre[4];
        const bf16_t* Kc_base = Pb + (size_t)(NLAT + b * CTXL) * INW + 1024 + kh * 128;
        const bf16_t* Kb_base = Pb + (size_t)(b * SEQ) * INW + 1024 + kh * 128;
        const bf16_t* Vc_base = VTC + (size_t)(b * 2 + kh) * 128 * CTXL;
        const bf16_t* Vb_base = VTL + (size_t)(b * 2 + kh) * 128 * SEQ;
#define ATT_LOAD(c) do { const bool band_ = (c) < nband; const int key0_ = band_ ? kb_lo * 128 + (c) * 64 : ((c) - nband) * 64; \
            const bf16_t* kb_ = band_ ? Kb_base : Kc_base; const bf16_t* vb_ = band_ ? Vb_base : Vc_base; const int lv_ = band_ ? SEQ : CTXL; \
            _Pragma("unroll") for (int i_ = 0; i_ < 2; ++i_) { const int p_ = tid + 512 * i_; \
                pre[i_] = *(const u32x4*)(kb_ + (size_t)(key0_ + (p_ >> 4)) * INW + (p_ & 15) * 8); \
                pre[2 + i_] = *(const u32x4*)(vb_ + (size_t)(p_ >> 3) * lv_ + key0_ + (p_ & 7) * 8); } } while (0)
        ATT_LOAD(0);
        __syncthreads();
#pragma unroll
        for (int i = 0; i < 2; ++i) { const int p = tid + 512 * i; *(PG8_LAS u32x4*)(Kl + (p >> 4) * 272 + (p & 15) * 16) = pre[i]; *(PG8_LAS u32x4*)(Vl + (p >> 3) * 144 + (p & 7) * 16) = pre[2 + i]; }
        __syncthreads();
        for (int c = 0; c < nch; ++c) {
            const LP Kc = Kl + (c & 1) * ATT_BUF, Vc = Vl + (c & 1) * ATT_BUF;
            if (c + 1 < nch) ATT_LOAD(c + 1);
            bool skip = false; int kblk = n;
            if (c < nband) { kblk = kb_lo + (c >> 1);
                if (kblk < n) skip = ((c & 1) == 0) && (qsub >= 2);
                else if (kblk > n) skip = ((c & 1) == 1) && (qsub < 2); }
            if (!skip) {
            f32x16 S0, S1;
#pragma unroll
            for (int i = 0; i < 16; ++i) { S0[i] = 0.f; S1[i] = 0.f; }
#pragma unroll
            for (int ks = 0; ks < 8; ++ks) { const bf16x8 k0 = *(const PG8_LAS bf16x8*)(Kc + r * 272 + (16 * ks + 8 * h) * 2), k1 = *(const PG8_LAS bf16x8*)(Kc + (32 + r) * 272 + (16 * ks + 8 * h) * 2);
                S0 = MFMA32(k0, qf[ks], S0); S1 = MFMA32(k1, qf[ks], S1); }
            const bool allvalid = (kblk < n) ? (((c & 1) == 1) && (qsub < 2)) : (((c & 1) == 0) && (qsub >= 2));
            if (kblk != n && !allvalid) { const int qi = n * 128 + qsub * 32 + r, kj0 = kblk * 128 + (c & 1) * 64 + 4 * h;
#pragma unroll
                for (int i = 0; i < 16; ++i) { const int kj = kj0 + (i & 3) + 8 * (i >> 2); int dd = qi - kj; dd = dd < 0 ? -dd : dd;
                    if (dd > 128) S0[i] = -1e30f; int d2 = qi - (kj + 32); d2 = d2 < 0 ? -d2 : d2; if (d2 > 128) S1[i] = -1e30f; } }
            float cmax = S0[0];
#pragma unroll
            for (int i = 1; i < 16; ++i) cmax = fmaxf(cmax, S0[i]);
#pragma unroll
            for (int i = 0; i < 16; ++i) cmax = fmaxf(cmax, S1[i]);
            { const auto r_ = __builtin_amdgcn_permlane32_swap(__float_as_uint(cmax), __float_as_uint(cmax), false, false); cmax = fmaxf(__uint_as_float(r_[0]), __uint_as_float(r_[1])); }
            const bool grew = cmax > m + 8.0f; const float mnew = grew ? cmax : m, alpha = __builtin_amdgcn_exp2f(m - mnew); m = mnew;
            float rs = 0.f;
#pragma unroll
            for (int i = 0; i < 16; ++i) { S0[i] = __builtin_amdgcn_exp2f(S0[i] - mnew); S1[i] = __builtin_amdgcn_exp2f(S1[i] - mnew); rs += S0[i] + S1[i]; }
            { const auto r_ = __builtin_amdgcn_permlane32_swap(__float_as_uint(rs), __float_as_uint(rs), false, false); rs = __uint_as_float(r_[0]) + __uint_as_float(r_[1]); }
            lsum = lsum * alpha + rs;
            if (__any(grew)) {
#pragma unroll
                for (int dt = 0; dt < 4; ++dt)
#pragma unroll
                    for (int i = 0; i < 16; ++i) O[dt][i] *= alpha; }
            bf16x8 pf[2][2];
#pragma unroll
            for (int s = 0; s < 2; ++s) { u32x4 a, bq;
                a.x = pk2(S0[8 * s + 0], S0[8 * s + 1]); a.y = pk2(S0[8 * s + 2], S0[8 * s + 3]); a.z = pk2(S0[8 * s + 4], S0[8 * s + 5]); a.w = pk2(S0[8 * s + 6], S0[8 * s + 7]);
                bq.x = pk2(S1[8 * s + 0], S1[8 * s + 1]); bq.y = pk2(S1[8 * s + 2], S1[8 * s + 3]); bq.z = pk2(S1[8 * s + 4], S1[8 * s + 5]); bq.w = pk2(S1[8 * s + 6], S1[8 * s + 7]);
                pf[0][s] = __builtin_bit_cast(bf16x8, a); pf[1][s] = __builtin_bit_cast(bf16x8, bq); }
#pragma unroll
            for (int dt = 0; dt < 4; ++dt)
#pragma unroll
                for (int kt = 0; kt < 2; ++kt)
#pragma unroll
                    for (int s = 0; s < 2; ++s) { const LP vp = Vc + (32 * dt + r) * 144 + (32 * kt + 16 * s + 4 * h) * 2;
                        const u32x2 lo = *(const PG8_LAS u32x2*)vp, hi = *(const PG8_LAS u32x2*)(vp + 16);
                        u32x4 vv; vv.x = lo.x; vv.y = lo.y; vv.z = hi.x; vv.w = hi.y;
                        O[dt] = MFMA32(__builtin_bit_cast(bf16x8, vv), pf[kt][s], O[dt]); }
            }
            if (c + 1 < nch) {
                const LP Kn = Kl + ((c + 1) & 1) * ATT_BUF, Vn = Vl + ((c + 1) & 1) * ATT_BUF;
#pragma unroll
                for (int i = 0; i < 2; ++i) { const int p = tid + 512 * i; *(PG8_LAS u32x4*)(Kn + (p >> 4) * 272 + (p & 15) * 16) = pre[i]; *(PG8_LAS u32x4*)(Vn + (p >> 3) * 144 + (p & 7) * 16) = pre[2 + i]; }
            }
            __syncthreads();
        }
#undef ATT_LOAD
        const float inv = 1.0f / lsum;
        bf16_t* op = MIX + (size_t)myrow * D + hq * 128 + 4 * h;
#pragma unroll
        for (int dt = 0; dt < 4; ++dt)
#pragma unroll
            for (int g = 0; g < 4; ++g) { u32x2 wv; wv.x = pk2(O[dt][4 * g] * inv, O[dt][4 * g + 1] * inv); wv.y = pk2(O[dt][4 * g + 2] * inv, O[dt][4 * g + 3] * inv);
                *(u32x2*)(op + 32 * dt + 8 * g) = wv; }
    }
}
DI void fixup_phase(CP P, int l) {
    unsigned char* ws = P->ws; const float* hb = (const float*)(ws + WS_HB); bf16_t* act = (bf16_t*)(ws + WS_ACT);
    const float* cw = P->in[I_CONVW] + (size_t)l * 3 * NUP; const float* cb = P->in[I_CONVB] + (size_t)l * NUP;
    const int nbd = l == 0 ? 128 : 120, total = nbd * (DFF / 4);
    for (int i = bid_l() * NTHR + tid_l(); i < total; i += gridDim.x * NTHR) {
        const int bd = i / (DFF / 4), ch = (i % (DFF / 4)) * 4;
        int blkB; if (bd < 120) { const int b = bd / 15, k = bd % 15 + 1; blkB = b * 16 + k; } else { blkB = 128 + 2 * (bd - 120) + 1; }
        const int blkA = blkB - 1, pn = ch >> 7, cl = ch & 127, ig = pn * 256 + cl, iv = ig + 128;
        const float* A2 = hb + ((size_t)blkA * 4 + 2) * NUP; const float* A3 = A2 + NUP; const float* B0 = hb + ((size_t)blkB * 4) * NUP; const float* B1 = B0 + NUP;
        const f32x4 gm2 = *(const f32x4*)(A2 + ig), gm1 = *(const f32x4*)(A3 + ig), g0 = *(const f32x4*)(B0 + ig), g1 = *(const f32x4*)(B1 + ig);
        const f32x4 vm2 = *(const f32x4*)(A2 + iv), vm1 = *(const f32x4*)(A3 + iv), v0 = *(const f32x4*)(B0 + iv), v1 = *(const f32x4*)(B1 + iv);
        const f32x4 w0g = *(const f32x4*)(cw + ch), w1g = *(const f32x4*)(cw + NUP + ch), w2g = *(const f32x4*)(cw + 2 * NUP + ch), bg = *(const f32x4*)(cb + ch);
        const f32x4 w0v = *(const f32x4*)(cw + DFF + ch), w1v = *(const f32x4*)(cw + NUP + DFF + ch), w2v = *(const f32x4*)(cw + 2 * NUP + DFF + ch), bv = *(const f32x4*)(cb + DFF + ch);
        const f32x4 cgA = bg + w0g * gm2 + w1g * gm1 + w2g * g0, cvA = bv + w0v * vm2 + w1v * vm1 + w2v * v0;
        const f32x4 cgB = bg + w0g * gm1 + w1g * g0 + w2g * g1, cvB = bv + w0v * vm1 + w1v * v0 + w2v * v1;
        f32x4 oA, oB;
#pragma unroll
        for (int e = 0; e < 4; ++e) { oA[e] = silu_f(cgA[e]) * cvA[e]; oB[e] = silu_f(cgB[e]) * cvB[e]; }
        u32x2 wa, wb; wa.x = pk2(oA[0], oA[1]); wa.y = pk2(oA[2], oA[3]); wb.x = pk2(oB[0], oB[1]); wb.y = pk2(oB[2], oB[3]);
        const size_t rowB = (size_t)blkB * 128;
        *(u32x2*)(act + (rowB - 1) * DFF + ch) = wa; *(u32x2*)(act + rowB * DFF + ch) = wb;
    }
}
#ifndef GEMM_ALIGN
#define GEMM_ALIGN true
#endif
#ifndef GEMM_SP2
#define GEMM_SP2 true
#endif
#define GEMM_CALL(EpiT, g, S, E) pg8::gemm_phase<EpiT, pg8::StaticOrder, GEMM_ALIGN, GEMM_SP2>(lds, g, S, E)
DI void gemm_in_phase(CP P, int l, LP lds, bool subset = false) {
    unsigned char* ws = P->ws; const bf16_t* H = (const bf16_t*)(ws + WS_H); const bf16_t* W = (const bf16_t*)(ws + WS_WIN + l * SZ_WIN); bf16_t* Pb = (bf16_t*)(ws + WS_P);
    { pg8::Gemm g; EpiP E; E.O = Pb; E.ldc = INW; g.A = H; g.Bt = W; g.M = l == 0 ? MT : NLAT; g.N = INW; g.K = D; E.row_off = 0; E.col_off = 0; E.gelu_from_pn = 8; E.ssq = (float*)(ws + WS_SSQ);
      pg8::StaticOrder S; S.init(g.M, g.N, gridDim.x, bid_l()); S.nkt = g.K / 64;
      if (subset) { const int b_ = bid_l(); if ((b_ >> 3) & 1) { S.init(g.M, g.N, 128, 0); S.nwg = 0; } else S.init(g.M, g.N, 128, (b_ >> 4) * 8 + (b_ & 7)); S.nkt = g.K / 64; }
      GEMM_CALL(EpiP, g, S, E); }
    if (l == 1) {
        pg8::Gemm g; g.A = H + (size_t)NLAT * D; g.Bt = W + (size_t)1024 * D; g.M = NCTX; g.N = 512; g.K = D;
        EpiKVPart E; E.kvp = (float*)(ws + WS_KVP);
        pg8::StaticOrder S; S.init(g.M, g.N, gridDim.x, bid_l()); S.nkt = g.K / 64; S.split = 1;
        GEMM_CALL(EpiKVPart, g, S, E);
        filler_phase(P, 3, lds);
    }
}
DI void gemm_res_phase(CP P, int l, int which, LP lds) {
    unsigned char* ws = P->ws; float* X = (float*)(ws + WS_X);
    pg8::Gemm g; g.M = l == 0 ? MT : NLAT; g.N = D;
    if (which == 0) { g.A = (const bf16_t*)(ws + WS_MIX); g.Bt = (const bf16_t*)(ws + WS_WOUT + l * SZ_WOUT); g.K = D; }
    else { g.A = (const bf16_t*)(ws + WS_ACT); g.Bt = (const bf16_t*)(ws + WS_WDN + l * SZ_WDN); g.K = DFF; }
    EpiRes E; E.out = X; E.gate = (const float*)(ws + WS_MOD) + ((size_t)l * 9 * 6 + (which ? 5 : 2)) * D;
    if (l == 0 && which == 0) { E.base_lat = P->in[I_X]; E.base_ctx = P->in[I_CTX]; } else { E.base_lat = X; E.base_ctx = X + (size_t)NLAT * D; }
    pg8::StaticOrder S; S.init(g.M, g.N, gridDim.x, bid_l()); S.nkt = g.K / 64; S.split = (gridDim.x == 256 && l == 0) ? 1 : 0;
    E.xpart = (float*)(ws + WS_XP);
    GEMM_CALL(EpiRes, g, S, E);
}
DI void gemm_up_phase(CP P, int l, LP lds) {
    unsigned char* ws = P->ws;
    pg8::Gemm g; g.A = (const bf16_t*)(ws + WS_H); g.Bt = (const bf16_t*)(ws + WS_WUP + l * SZ_WUP); g.M = l == 0 ? MT : NLAT; g.N = NUP; g.K = D;
    EpiConvGlu E; E.act = (bf16_t*)(ws + WS_ACT); E.hb = (float*)(ws + WS_HB); E.cw = P->in[I_CONVW] + (size_t)l * 3 * NUP; E.cb = P->in[I_CONVB] + (size_t)l * NUP;
    pg8::StaticOrder S; S.init(g.M, g.N, gridDim.x, bid_l()); S.nkt = g.K / 64;
    GEMM_CALL(EpiConvGlu, g, S, E);
}
__global__ void __launch_bounds__(NTHR, 2) fwd_kernel(Params Parg) {
    extern __shared__ __attribute__((aligned(16))) unsigned char lds_raw[];
    const LP lds = (LP)lds_raw;
    cg::grid_group grid = cg::this_grid();
    const int lo = Parg.ph_lo, hi = Parg.ph_hi; int ph = 0;
    if (lo < 0) grid.sync();
    volatile PG8_LAS unsigned* xst = (volatile PG8_LAS unsigned*)(lds + 131072);
    if (threadIdx.x < 4) xst[threadIdx.x] = 0u;
    __syncthreads();
    XcdBarrier xbar = xcd_barrier_post((unsigned*)(Parg.ws + WS_BAR), xst);
#ifndef REP_MASK
#define REP_MASK 0u
#endif
#ifndef EXTRA_SYNCS
#define EXTRA_SYNCS 0
#endif
#ifndef PH_MASK
#define PH_MASK 0xffffffffu
#endif
#define PHASE(id, body) do { if (ph >= lo && ph < hi) { if ((PH_MASK >> (id)) & 1u) { auto kp_ = __builtin_amdgcn_kernarg_segment_ptr(); asm volatile("" : "+s"(kp_)); const CP P = (CP)kp_; body; if ((REP_MASK >> (id)) & 1u) { xcd_barrier(xbar); body; } } if (ph + 1 < hi) xcd_barrier(xbar); for (int xs_ = 0; xs_ < EXTRA_SYNCS; ++xs_) xcd_barrier(xbar); } ++ph; } while (0)
    PHASE(0, prep_phase(P, lds));
#pragma nounroll
    for (int l = 0; l < 2; ++l) {
        const int M = l == 0 ? MT : NLAT;
        PHASE(1, norm_mod_phase(P, l, 0, MT, lds));
        do { if (ph >= lo && ph < hi) { { auto kp_ = __builtin_amdgcn_kernarg_segment_ptr(); asm volatile("" : "+s"(kp_)); const CP P = (CP)kp_; gemm_in_phase(P, l, lds); if (l == 0) filler_phase(P, 0, lds); }
#ifdef SUBSET_PROBE
            xcd_barrier(xbar); { auto kp_ = __builtin_amdgcn_kernarg_segment_ptr(); asm volatile("" : "+s"(kp_)); const CP P = (CP)kp_; gemm_in_phase(P, l, lds, true); }
#endif
            if (ph + 1 < hi) xcd_barrier(xbar); } ++ph; } while (0);
        PHASE(3, { if ((PH_MASK >> 11) & 1u) qk_phase(P, l); for (int rp_ = 0; rp_ <= (int)((REP_MASK >> 12) & 1u); ++rp_) vt_phase(P, l, lds); for (int rp_ = 0; rp_ <= (int)((REP_MASK >> 13) & 1u); ++rp_) pool_phase(P, l, lds); for (int rp_ = 0; rp_ <= (int)((REP_MASK >> 14) & 1u); ++rp_) sgu_phase(P, l, lds); });
        PHASE(4, { attn_phase(P, l, lds); if (l == 0) filler_phase(P, 2, lds); });
        PHASE(5, { gemm_res_phase(P, l, 0, lds); });
        PHASE(6, norm_mod_phase(P, l, 1, M, lds));
        PHASE(7, { gemm_up_phase(P, l, lds); if (l == 0) filler_phase(P, 1, lds); });
        PHASE(8, fixup_phase(P, l));
        PHASE(9, { gemm_res_phase(P, l, 1, lds); });
    }
    PHASE(10, final_norm_phase(P));
#undef PHASE
}
constexpr int N_PHASES = 20;

extern "C" void kernel_launch(void* const* d_in, const int* in_sizes, int n_in, void* d_out, int out_size, void* d_ws, size_t ws_size, hipStream_t stream) {
    static int grid = 0;
    if (grid == 0) {
        if (n_in != N_IN || ws_size < WS_END) { fprintf(stderr, "kernel_launch: need %d inputs and >= %zu bytes of workspace; got %d, %zu\n", (int)N_IN, (size_t)WS_END, n_in, ws_size); grid = -1; return; }
        int dev = 0, cus = 0, per_cu = 0;
        if (hipGetDevice(&dev) != hipSuccess || hipDeviceGetAttribute(&cus, hipDeviceAttributeMultiprocessorCount, dev) != hipSuccess) { fprintf(stderr, "kernel_launch: device query failed\n"); grid = -1; return; }
        if (hipFuncSetAttribute((const void*)fwd_kernel, hipFuncAttributeMaxDynamicSharedMemorySize, LDS_BYTES) != hipSuccess) { fprintf(stderr, "kernel_launch: hipFuncSetAttribute failed\n"); grid = -1; return; }
        if (hipOccupancyMaxActiveBlocksPerMultiprocessor(&per_cu, (const void*)fwd_kernel, NTHR, LDS_BYTES) != hipSuccess || per_cu < 1) { fprintf(stderr, "kernel_launch: occupancy query says %d blocks/CU\n", per_cu); (void)hipGetLastError(); }
        grid = cus;
    }
    if (grid < 0) return;
    if (hipMemsetAsync((unsigned char*)d_ws + WS_BAR, 0, 16384, stream) != hipSuccess) { fprintf(stderr, "kernel_launch: memset of the barrier words failed\n"); return; }
    Params p{};
    for (int i = 0; i < N_IN; ++i) p.in[i] = (const float*)d_in[i];
    p.out = (float*)d_out; p.ws = (unsigned char*)d_ws; p.ph_lo = 0; p.ph_hi = N_PHASES;
    void* args[] = {&p};
    const hipError_t e = hipLaunchCooperativeKernel((const void*)fwd_kernel, dim3(grid), dim3(NTHR), args, LDS_BYTES, stream);
    if (e != hipSuccess) fprintf(stderr, "kernel_launch: cooperative launch failed: %s (grid %d)\n", hipGetErrorString(e), grid);
}
```

```cpp
#define REP_MASK 0u
#define EXTRA_SYNCS 0
#include <hip/hip_runtime.h>
#include <hip/hip_cooperative_groups.h>
#include <cstdio>
#include <cstdint>
namespace cg = cooperative_groups;
namespace pg8 {
#define PG8_LAS __attribute__((address_space(3)))
typedef unsigned short bf16_t;
typedef short bf16x8 __attribute__((ext_vector_type(8)));
typedef float f32x4 __attribute__((ext_vector_type(4)));
typedef unsigned u32x4 __attribute__((ext_vector_type(4)));
constexpr int BM = 256, BK = 64, HALF = 128, HTB = HALF * BK * 2  , STAGE_BYTES = 8 * HTB, NXCD = 8, WGM = 4;

__host__ __device__ __forceinline__ int lds_byte(int r, int c) { const int st = (r >> 4) * 2 + (c >> 5), rr = r & 15, cc = c & 31, ob = rr * 64 + cc * 2; return st * 1024 + (ob ^ (((ob >> 9) & 1) << 5)); }
__host__ __device__ __forceinline__ void stage_rc(int b, int& R, int& C) { const int st = b / 1024, sb = b % 1024, swz = sb ^ (((sb >> 9) & 1) << 5); R = (st >> 1) * 16 + swz / 64; C = (st & 1) * 32 + (swz % 64) / 2; }
__host__ __device__ __forceinline__ int perm32(int rho) { const int n = rho >> 4, i = rho & 15; return 8 * (i >> 2) + 4 * n + (i & 3); }

struct Unit { int pm, pn, kt0, nkt, part, tidx; };
struct Gemm { const bf16_t* A; const bf16_t* Bt; int M, N, K; };

struct StaticOrder {
    int nM, nN, nwg, G, c;
    __host__ __device__ void init(int M, int N, int G_, int c_) { nM = M / BM; nN = N / BM; nwg = nM * nN; G = G_; c = c_; }
    __host__ __device__ bool next(int i, Unit& u) const {
        const long L = (long)i * G + c; if (L >= nwg) return false;
        int wgid = (int)L; { const int q = nwg / NXCD, r = nwg % NXCD, xcd = wgid % NXCD, off = wgid / NXCD; wgid = (xcd < r ? xcd * (q + 1) : r * (q + 1) + (xcd - r) * q) + off; }
        const int nig = WGM * nN, gid = wgid / nig, fm = gid * WGM, gsz = (nM - fm) < WGM ? (nM - fm) : WGM;
        u.pm = fm + ((wgid % nig) % gsz); u.pn = (wgid % nig) / gsz; u.kt0 = 0; u.nkt = nkt; u.part = 0; u.tidx = 0; return true;
    }
    int nkt = 0;
    int split = 0;
    __host__ __device__ bool next_split(int i, Unit& u) const {
        const int full = nwg / G;
        if (!split || i < full) return next(i, u);
        if (i > full) return false;
        const int x = c & 7, j = c >> 3, cp = (j >> 2) * 8 + x, quarter = j & 3;
        StaticOrder t = *this; t.c = cp;
        if (!t.next(full, u)) return false;
        u.nkt = nkt >> 2; u.kt0 = quarter * u.nkt; u.part = quarter; u.tidx = cp; return true;
    }
    __device__ __forceinline__ void a_ready(const Unit&) const {}
    __device__ __forceinline__ void done(const Unit&) const {}
};
typedef float f32x2 __attribute__((ext_vector_type(2)));
__device__ __forceinline__ f32x2 gelu_pk(f32x2 v) {
    const f32x2 av = __builtin_elementwise_abs(v), d = av * 0.2316418882f + 1.0f;
    f32x2 t; t.x = __builtin_amdgcn_rcpf(d.x); t.y = __builtin_amdgcn_rcpf(d.y);
    f32x2 q = t * 0.5307027145f + (-0.7265760135f); q = q * t + 0.7107068705f; q = q * t + (-0.142248368f); q = q * t + 0.127414796f; q = q * t;
    const f32x2 s = (v * v) * (-0.72134752044f);
    f32x2 e; e.x = __builtin_amdgcn_exp2f(s.x); e.y = __builtin_amdgcn_exp2f(s.y);
    const f32x2 m = v * (q * e), r = v - m;
    f32x2 o; o.x = v.x < 0.f ? m.x : r.x; o.y = v.y < 0.f ? m.y : r.y; return o;
}

template <class Epi, class Sched, bool ALIGN_EPI = false, bool SP2 = false>
__device__ __forceinline__ void gemm_phase(PG8_LAS unsigned char* lds, const Gemm g, const Sched& S, const Epi& E) {
    int tid = threadIdx.x; asm volatile("" : "+v"(tid)); const int wid = __builtin_amdgcn_readfirstlane(tid >> 6), lane = tid & 63, wr = wid >> 2, wc = wid & 3, fr = lane & 15, fq = lane >> 4;
    const int K = g.K;
    unsigned voffA[2], voffB[2];
#pragma unroll
    for (int i = 0; i < 2; ++i) { int R, C; stage_rc(tid * 16 + i * 8192, R, C); const int Rb = Epi::PERM ? ((R & ~31) + perm32(R & 31)) : R;
        const int Ra = Epi::ROWPERM ? (128 * ((R >> 6) & 1) + 8 * (R & 15) + ((R >> 4) & 3)) : R; voffA[i] = (unsigned)(Ra * K + C) * 2u; voffB[i] = (unsigned)(Rb * K + C) * 2u; }
    const size_t kstep = (size_t)(BK * 2);
    const size_t hstep = (size_t)HALF * K * 2;
    const size_t tstep = 2 * hstep; const size_t hstepA = Epi::ROWPERM ? (size_t)4 * K * 2 : hstep;
    const unsigned ldsw = (unsigned)wid * 1024u;
    const int aoff = lds_byte(wr * 64 + fr, fq * 8), boff = lds_byte(wc * 32 + fr, fq * 8);
#define PG8_SA(b, h) (((b) * 2 + (h)) * HTB)
#define PG8_SB(b, h) ((4 + (b) * 2 + (h)) * HTB)
#define PG8_STAGE(bufoff, gbase, voff) do { _Pragma("unroll") for (int _i = 0; _i < 2; ++_i) \
        __builtin_amdgcn_global_load_lds((const unsigned*)((const char*)(gbase) + (voff)[_i]), (PG8_LAS unsigned*)(lds + (bufoff) + ldsw + _i * 8192), 16, 0, 0); } while (0)
#define PG8_LDA(dst, b, h) do { _Pragma("unroll") for (int m = 0; m < 4; ++m) _Pragma("unroll") for (int k = 0; k < 2; ++k) dst[m][k] = *(const PG8_LAS bf16x8*)(lds + PG8_SA(b, h) + aoff + m * 2048 + k * 1024); } while (0)
#define PG8_LDB(dst, b, h) do { _Pragma("unroll") for (int n = 0; n < 2; ++n) _Pragma("unroll") for (int k = 0; k < 2; ++k) dst[n][k] = *(const PG8_LAS bf16x8*)(lds + PG8_SB(b, h) + boff + n * 2048 + k * 1024); } while (0)
#define PG8_MMA(ai, bj, At, Bt) do { __builtin_amdgcn_s_setprio(1); _Pragma("unroll") for (int m = 0; m < 4; ++m) _Pragma("unroll") for (int n = 0; n < 2; ++n) _Pragma("unroll") for (int k = 0; k < 2; ++k) \
        acc[ai][bj][m][n] = __builtin_amdgcn_mfma_f32_16x16x32_bf16(Bt[n][k], At[m][k], acc[ai][bj][m][n], 0, 0, 0); __builtin_amdgcn_s_setprio(0); } while (0)
#define PG8_WAIT_V(n) asm volatile("s_waitcnt vmcnt(" #n ")" ::: "memory")
#define PG8_WAIT_L(n) asm volatile("s_waitcnt lgkmcnt(" #n ")" ::: "memory")
#define PG8_BAR __builtin_amdgcn_s_barrier()
#define PG8_SCHED __builtin_amdgcn_sched_barrier(0)
    Unit cur, nxt; int ui = 0;
    if (!S.next_split(0, cur)) return;
    f32x4 acc[2][2][4][2];
#pragma unroll
    for (int a = 0; a < 2; ++a)
#pragma unroll
        for (int b = 0; b < 2; ++b)
#pragma unroll
            for (int m = 0; m < 4; ++m)
#pragma unroll
                for (int n = 0; n < 2; ++n) acc[a][b][m][n] = (f32x4){0.f, 0.f, 0.f, 0.f};
    bf16x8 At[4][2], B0[2][2], B1[2][2];
    const char* cA = (const char*)g.A + (size_t)cur.pm * tstep + (size_t)cur.kt0 * kstep; const char* cB = (const char*)g.Bt + (size_t)cur.pn * tstep + (size_t)cur.kt0 * kstep;
    S.a_ready(cur);
    if constexpr (SP2) {
        PG8_STAGE(PG8_SB(0, 0), cB, voffB); PG8_STAGE(PG8_SB(0, 1), cB + hstep, voffB); PG8_STAGE(PG8_SA(0, 0), cA, voffA); PG8_STAGE(PG8_SA(0, 1), cA + hstepA, voffA);
        if (wr == 1) PG8_BAR;
        PG8_WAIT_V(2); PG8_BAR;
        PG8_STAGE(PG8_SB(1, 0), cB + kstep, voffB); PG8_STAGE(PG8_SA(1, 0), cA + kstep, voffA); PG8_STAGE(PG8_SB(1, 1), cB + hstep + kstep, voffB);
        PG8_WAIT_V(6); PG8_BAR;
    } else {
        PG8_STAGE(PG8_SB(0, 0), cB, voffB); PG8_STAGE(PG8_SA(0, 0), cA, voffA); PG8_STAGE(PG8_SB(0, 1), cB + hstep, voffB); PG8_STAGE(PG8_SA(0, 1), cA + hstepA, voffA);
        if (wr == 1) PG8_BAR;
        PG8_WAIT_V(4); PG8_BAR;
        PG8_STAGE(PG8_SB(1, 0), cB + kstep, voffB); PG8_STAGE(PG8_SA(1, 0), cA + kstep, voffA); PG8_STAGE(PG8_SB(1, 1), cB + hstep + kstep, voffB);
        PG8_WAIT_V(6); PG8_BAR;
    }
    for (;;) {
        const bool has_next = S.next_split(ui + 1, nxt); const int nt = cur.nkt;
        const char* nA = has_next ? (const char*)g.A + (size_t)nxt.pm * tstep + (size_t)nxt.kt0 * kstep : cA; const char* nB = has_next ? (const char*)g.Bt + (size_t)nxt.pn * tstep + (size_t)nxt.kt0 * kstep : cB;
        for (int t = 0; t < nt; t += 2) {
            const bool last = (t == nt - 2);
            const char* a1 = cA + (size_t)(t + 1) * kstep;
            const char* a2 = last ? nA : cA + (size_t)(t + 2) * kstep; const char* b2 = last ? nB : cB + (size_t)(t + 2) * kstep;
            const char* a3 = a2 + kstep; const char* b3 = b2 + kstep;
            if (last && has_next) S.a_ready(nxt);
            if constexpr (SP2) {
            PG8_LDB(B0, 0, 0); PG8_LDB(B1, 0, 1); PG8_SCHED; PG8_LDA(At, 0, 0); PG8_STAGE(PG8_SA(1, 1), a1 + hstepA, voffA);
            PG8_WAIT_V(8); PG8_WAIT_L(0); PG8_BAR; PG8_MMA(0, 0, At, B0); PG8_MMA(0, 1, At, B1); PG8_BAR; PG8_SCHED;
            PG8_LDA(At, 0, 1); PG8_STAGE(PG8_SB(0, 0), b2, voffB); PG8_STAGE(PG8_SB(0, 1), b2 + hstep, voffB); PG8_STAGE(PG8_SA(0, 0), a2, voffA);
            PG8_WAIT_V(8); PG8_WAIT_L(0); PG8_BAR; PG8_MMA(1, 0, At, B0); PG8_MMA(1, 1, At, B1); PG8_BAR; PG8_SCHED;
            PG8_LDB(B0, 1, 0); PG8_LDB(B1, 1, 1); PG8_SCHED; PG8_LDA(At, 1, 0); PG8_STAGE(PG8_SA(0, 1), a2 + hstepA, voffA);
            PG8_WAIT_V(8); PG8_WAIT_L(0); PG8_BAR; PG8_MMA(0, 0, At, B0); PG8_MMA(0, 1, At, B1); PG8_BAR; PG8_SCHED;
            PG8_LDA(At, 1, 1); PG8_STAGE(PG8_SB(1, 0), b3, voffB); PG8_STAGE(PG8_SB(1, 1), b3 + hstep, voffB); PG8_STAGE(PG8_SA(1, 0), a3, voffA);
            PG8_WAIT_V(8); PG8_WAIT_L(0); PG8_BAR; PG8_MMA(1, 0, At, B0); PG8_MMA(1, 1, At, B1); PG8_BAR; PG8_SCHED;
            } else {
            PG8_LDB(B0, 0, 0); PG8_SCHED; PG8_LDA(At, 0, 0); PG8_STAGE(PG8_SA(1, 1), a1 + hstepA, voffA);
            PG8_WAIT_L(8); PG8_BAR; PG8_WAIT_L(0); PG8_MMA(0, 0, At, B0); PG8_BAR; PG8_SCHED;
            PG8_LDB(B1, 0, 1); PG8_STAGE(PG8_SB(0, 0), b2, voffB);
            PG8_BAR; PG8_WAIT_L(0); PG8_MMA(0, 1, At, B1); PG8_BAR;
            PG8_LDA(At, 0, 1); PG8_STAGE(PG8_SA(0, 0), a2, voffA);
            PG8_BAR; PG8_WAIT_L(0); PG8_MMA(1, 0, At, B0); PG8_BAR; PG8_SCHED;
            PG8_STAGE(PG8_SB(0, 1), b2 + hstep, voffB);
            PG8_WAIT_V(6); PG8_BAR; PG8_MMA(1, 1, At, B1); PG8_BAR;
            PG8_LDB(B0, 1, 0); PG8_SCHED; PG8_LDA(At, 1, 0); PG8_STAGE(PG8_SA(0, 1), a2 + hstepA, voffA);
            PG8_WAIT_L(8); PG8_BAR; PG8_WAIT_L(0); PG8_MMA(0, 0, At, B0); PG8_BAR; PG8_SCHED;
            PG8_LDB(B1, 1, 1); PG8_STAGE(PG8_SB(1, 0), b3, voffB);
            PG8_BAR; PG8_WAIT_L(0); PG8_MMA(0, 1, At, B1); PG8_BAR;
            PG8_LDA(At, 1, 1); PG8_STAGE(PG8_SA(1, 0), a3, voffA);
            PG8_BAR; PG8_WAIT_L(0); PG8_MMA(1, 0, At, B0); PG8_BAR; PG8_SCHED;
            PG8_STAGE(PG8_SB(1, 1), b3 + hstep, voffB);
            PG8_WAIT_V(6); PG8_BAR; PG8_MMA(1, 1, At, B1); PG8_BAR;
            }
        }
        if constexpr (ALIGN_EPI) { if (wr == 0) PG8_BAR; }
        if constexpr (!Epi::AFTER_DRAIN) { E(acc, cur, wr, wc, fr, fq); S.done(cur); }
        if (!has_next) break;
#pragma unroll
        for (int a = 0; a < 2; ++a)
#pragma unroll
            for (int b = 0; b < 2; ++b)
#pragma unroll
                for (int m = 0; m < 4; ++m)
#pragma unroll
                    for (int n = 0; n < 2; ++n) acc[a][b][m][n] = (f32x4){0.f, 0.f, 0.f, 0.f};
        cur = nxt; cA = nA; cB = nB; ++ui;
        if constexpr (ALIGN_EPI) { if (wr == 1) PG8_BAR; }
    }
    PG8_WAIT_V(0);
    if constexpr (!ALIGN_EPI) { if (wr == 0) PG8_BAR; }
    PG8_BAR;
    if constexpr (Epi::AFTER_DRAIN) { E.fused(acc, cur, wr, wc, fr, fq, lds, wid, lane); S.done(cur); }
#undef PG8_SA
#undef PG8_SB
#undef PG8_STAGE
#undef PG8_LDA
#undef PG8_LDB
#undef PG8_MMA
#undef PG8_WAIT_V
#undef PG8_WAIT_L
#undef PG8_BAR
#undef PG8_SCHED
}
}
using pg8::bf16_t; using pg8::bf16x8; using pg8::f32x4; using pg8::u32x4; using pg8::Unit;
typedef PG8_LAS unsigned char* LP;
typedef unsigned u32x2 __attribute__((ext_vector_type(2)));
typedef float f32x2 __attribute__((ext_vector_type(2)));
typedef float f32x16 __attribute__((ext_vector_type(16)));
typedef __bf16 bf16x2_t __attribute__((ext_vector_type(2)));
#define DI __device__ __forceinline__

constexpr int D = 2048, NB = 8, SEQ = 2048, CTXL = 256, NLAT = NB * SEQ, NCTX = NB * CTXL, MT = NLAT + NCTX;
constexpr int INW = 3072, DFF = 5632, NUP = 2 * DFF;
constexpr int NTHR = 512;
constexpr float EPS = 1e-6f;
constexpr float LOG2E = 1.4426950408889634f;
constexpr float QSCALE = 0.08838834764831845f * 1.4426950408889634f;
constexpr int LDS_BYTES = 131072 + 16;
enum { I_X = 0, I_C, I_CTX, I_CCTX, I_N1G, I_N2G, I_WADA, I_BADA, I_WIN, I_QNG, I_KNG, I_SINK, I_POOLW, I_POOLS, I_SGUNG, I_SGUW, I_SGUB, I_WOUT, I_WUP, I_CONVW, I_CONVB, I_WDOWN, I_FNG, N_IN };
constexpr size_t SZ_WIN = (size_t)INW * D * 2, SZ_WOUT = (size_t)D * D * 2, SZ_WUP = (size_t)NUP * D * 2, SZ_WDN = (size_t)D * DFF * 2;
constexpr size_t WS_WIN = 0, WS_WOUT = WS_WIN + 2 * SZ_WIN, WS_WUP = WS_WOUT + 2 * SZ_WOUT, WS_WDN = WS_WUP + 2 * SZ_WUP;
constexpr size_t WS_BAR = WS_WDN + 2 * SZ_WDN;
constexpr size_t WS_MOD = WS_BAR + 16384;
constexpr size_t WS_ROPE = WS_MOD + (size_t)2 * 9 * 6 * D * 4;
constexpr size_t WS_H = WS_ROPE + 64 * 32 * 2 * 4;
constexpr size_t WS_X = WS_H + (size_t)MT * D * 2;
constexpr size_t WS_HB = WS_X + (size_t)MT * D * 4;
constexpr size_t WS_R1 = WS_HB + (size_t)144 * 4 * NUP * 4;
constexpr size_t WS_P = WS_R1;
constexpr size_t WS_MIX = WS_P + (size_t)MT * INW * 2;
constexpr size_t WS_VTL = WS_MIX + (size_t)MT * D * 2;
constexpr size_t WS_VTC = WS_VTL + (size_t)NB * 2 * 128 * SEQ * 2;
constexpr size_t WS_R1_END_A = WS_VTC + (size_t)NB * 2 * 128 * CTXL * 2;
constexpr size_t WS_ACT = WS_R1;
constexpr size_t WS_R1_END_B = WS_ACT + (size_t)MT * DFF * 2;
constexpr size_t WS_XP = WS_R1_END_A > WS_R1_END_B ? WS_R1_END_A : WS_R1_END_B;
constexpr size_t WS_KVP = WS_XP + (size_t)64 * 3 * 65536 * 4;
constexpr size_t WS_SSQ = WS_KVP + (size_t)4 * NCTX * 512 * 4;
constexpr size_t WS_END = WS_SSQ + (size_t)MT * 4;

struct Params { const float* in[N_IN]; float* out; unsigned char* ws; int ph_lo, ph_hi; };
typedef const __attribute__((address_space(4))) Params* CP;

DI int tid_l() { int t = threadIdx.x; asm volatile("" : "+v"(t)); return t; }
DI int bid_l() { int b = blockIdx.x; asm volatile("" : "+s"(b)); return b; }
DI unsigned pk2(float a, float b) { f32x2 v = {a, b}; bf16x2_t r = __builtin_convertvector(v, bf16x2_t); return __builtin_bit_cast(unsigned, r); }
DI float bf_lo(unsigned w) { return __uint_as_float(w << 16); }
DI float bf_hi(unsigned w) { return __uint_as_float(w & 0xffff0000u); }
DI float silu_f(float x) { return x * __builtin_amdgcn_rcpf(1.0f + __builtin_amdgcn_exp2f(-x * LOG2E)); }
DI float gelu_f(float x) { f32x2 v = {x, x}; return pg8::gelu_pk(v).x; }
DI f32x4 gelu4(f32x4 x) { f32x2 a = pg8::gelu_pk((f32x2){x[0], x[1]}), b = pg8::gelu_pk((f32x2){x[2], x[3]}); return (f32x4){a.x, a.y, b.x, b.y}; }

struct EpiP {
    static constexpr bool PERM = true, AFTER_DRAIN = false, ROWPERM = false;
    float* ssq;
    bf16_t* O; int ldc, row_off, col_off, gelu_from_pn;
    DI void operator()(const f32x4 (&acc)[2][2][4][2], const Unit& u, int wr, int wc, int fr, int fq) const {
        const int row0 = row_off + u.pm * 256 + wr * 64 + fr, col0 = col_off + u.pn * 256 + wc * 32 + 8 * fq;
        const bool gsq = (u.pn >= 10) && (gelu_from_pn < 12);
#pragma unroll
        for (int ai = 0; ai < 2; ++ai)
#pragma unroll
            for (int m = 0; m < 4; ++m) { bf16_t* rowp = O + (size_t)(row0 + ai * 128 + m * 16) * ldc + col0; float s = 0.f;
#pragma unroll
                for (int bj = 0; bj < 2; ++bj) { f32x4 v0 = acc[ai][bj][m][0], v1 = acc[ai][bj][m][1];
                    if (u.pn >= gelu_from_pn) { v0 = gelu4(v0); v1 = gelu4(v1); }
                    s += v0[0] * v0[0] + v0[1] * v0[1] + v0[2] * v0[2] + v0[3] * v0[3] + v1[0] * v1[0] + v1[1] * v1[1] + v1[2] * v1[2] + v1[3] * v1[3];
                    u32x4 w; w.x = pk2(v0[0], v0[1]); w.y = pk2(v0[2], v0[3]); w.z = pk2(v1[0], v1[1]); w.w = pk2(v1[2], v1[3]);
                    *(u32x4*)(rowp + bj * 128) = w; }
                if (gsq) { s += __shfl_xor(s, 16); s += __shfl_xor(s, 32); if (fq == 0) atomicAdd(ssq + row0 + ai * 128 + m * 16, s); } }
    }
};
struct EpiKVPart {
    static constexpr bool PERM = false, AFTER_DRAIN = false, ROWPERM = false;
    float* kvp;
    DI void operator()(const f32x4 (&acc)[2][2][4][2], const Unit& u, int wr, int wc, int fr, int fq) const {
        float* op = kvp + ((size_t)u.part * NCTX + u.pm * 256 + wr * 64 + fr) * 512 + u.pn * 256 + wc * 32 + 4 * fq;
#pragma unroll
        for (int ai = 0; ai < 2; ++ai)
#pragma unroll
            for (int m = 0; m < 4; ++m)
#pragma unroll
                for (int bj = 0; bj < 2; ++bj)
#pragma unroll
                    for (int n = 0; n < 2; ++n) *(f32x4*)(op + (size_t)(ai * 128 + m * 16) * 512 + bj * 128 + n * 16) = acc[ai][bj][m][n];
    }
};
struct EpiRes {
    static constexpr bool PERM = false, AFTER_DRAIN = false, ROWPERM = false;
    const float* base_lat; const float* base_ctx; float* out; float* xpart; const float* gate;
    DI void operator()(const f32x4 (&acc)[2][2][4][2], const Unit& u, int wr, int wc, int fr, int fq) const {
        const int row0 = u.pm * 256 + wr * 64 + fr, col0 = u.pn * 256 + wc * 32 + 4 * fq;
        const int b = u.pm < 64 ? (u.pm >> 3) : 8;
        const float* gp = gate + (size_t)b * 6 * D + col0;
        f32x4 gv[2][2];
#pragma unroll
        for (int bj = 0; bj < 2; ++bj)
#pragma unroll
            for (int n = 0; n < 2; ++n) gv[bj][n] = *(const f32x4*)(gp + bj * 128 + n * 16);
        if (u.part != 0) {
            float* xp = xpart + ((size_t)(u.tidx * 3 + u.part - 1) << 16) + (size_t)(wr * 64 + fr) * 256 + wc * 32 + 4 * fq;
#pragma unroll
            for (int ai = 0; ai < 2; ++ai)
#pragma unroll
                for (int m = 0; m < 4; ++m)
#pragma unroll
                    for (int bj = 0; bj < 2; ++bj)
#pragma unroll
                        for (int n = 0; n < 2; ++n) *(f32x4*)(xp + (size_t)(ai * 128 + m * 16) * 256 + bj * 128 + n * 16) = gv[bj][n] * acc[ai][bj][m][n];
            return;
        }
        const float* bp = (u.pm < 64 ? base_lat + (size_t)row0 * D : base_ctx + (size_t)(row0 - NLAT) * D) + col0;
        float* op = out + (size_t)row0 * D + col0;
        f32x4 bs[4], bn[4];
#pragma unroll
        for (int q = 0; q < 4; ++q) bs[q] = *(const f32x4*)(bp + (q >> 1) * 128 + (q & 1) * 16);
#pragma unroll
        for (int g = 0; g < 8; ++g) { const int ai = g >> 2, m = g & 3; const size_t off = (size_t)(ai * 128 + m * 16) * D;
            if (g < 7) { const size_t offn = (size_t)(((g + 1) >> 2) * 128 + ((g + 1) & 3) * 16) * D;
#pragma unroll
                for (int q = 0; q < 4; ++q) bn[q] = *(const f32x4*)(bp + offn + (q >> 1) * 128 + (q & 1) * 16); }
#pragma unroll
            for (int q = 0; q < 4; ++q) { const int bj = q >> 1, n = q & 1; *(f32x4*)(op + off + bj * 128 + n * 16) = bs[q] + gv[bj][n] * acc[ai][bj][m][n]; }
            asm volatile("" ::: "memory");
#pragma unroll
            for (int q = 0; q < 4; ++q) bs[q] = bn[q]; }
    }
};
struct EpiConvGlu {
    static constexpr bool PERM = true, AFTER_DRAIN = false, ROWPERM = true;
    bf16_t* act; float* hb; const float* cw; const float* cb;
    DI void operator()(const f32x4 (&acc)[2][2][4][2], const Unit& u, int wr, int wc, int fr, int fq) const {
        const int tok0 = u.pm * 256 + 128 * wr + 8 * fr, cl0 = wc * 32 + 8 * fq;
#pragma unroll
        for (int n = 0; n < 2; ++n) {
            const int cl = cl0 + 4 * n, chg = u.pn * 128 + cl, chv = DFF + chg;
            const f32x4 w0g = *(const f32x4*)(cw + chg), w1g = *(const f32x4*)(cw + NUP + chg), w2g = *(const f32x4*)(cw + 2 * NUP + chg), bg = *(const f32x4*)(cb + chg);
            const f32x4 w0v = *(const f32x4*)(cw + chv), w1v = *(const f32x4*)(cw + NUP + chv), w2v = *(const f32x4*)(cw + 2 * NUP + chv), bv = *(const f32x4*)(cb + chv);
            f32x4 gp, gn, vp, vn;
#pragma unroll
            for (int e = 0; e < 4; ++e) {
                gp[e] = __int_as_float(__builtin_amdgcn_update_dpp(0, __float_as_int(acc[1][0][3][n][e]), 0x111, 0xf, 0xf, true)); gn[e] = __int_as_float(__builtin_amdgcn_update_dpp(0, __float_as_int(acc[0][0][0][n][e]), 0x101, 0xf, 0xf, true));
                vp[e] = __int_as_float(__builtin_amdgcn_update_dpp(0, __float_as_int(acc[1][1][3][n][e]), 0x111, 0xf, 0xf, true)); vn[e] = __int_as_float(__builtin_amdgcn_update_dpp(0, __float_as_int(acc[0][1][0][n][e]), 0x101, 0xf, 0xf, true)); }
            if (fr == 0) { gp = (f32x4){0.f, 0.f, 0.f, 0.f}; vp = gp; }
            if (fr == 15) { gn = (f32x4){0.f, 0.f, 0.f, 0.f}; vn = gn; }
            if (fr == 0 || fr == 15) {
                float* hp = hb + ((size_t)(u.pm * 2 + wr) * 4 + (fr ? 2 : 0)) * NUP + u.pn * 256 + cl;
                const int j0 = fr ? 6 : 0;
                const f32x4 g0 = fr ? acc[1][0][2][n] : acc[0][0][0][n], g1 = fr ? acc[1][0][3][n] : acc[0][0][1][n];
                const f32x4 v0 = fr ? acc[1][1][2][n] : acc[0][1][0][n], v1 = fr ? acc[1][1][3][n] : acc[0][1][1][n];
                (void)j0;
                *(f32x4*)(hp) = g0; *(f32x4*)(hp + 128) = v0; *(f32x4*)(hp + NUP) = g1; *(f32x4*)(hp + NUP + 128) = v1;
            }
#pragma unroll
            for (int j = 0; j < 8; ++j) {
                const f32x4 gP = j ? acc[(j - 1) >> 2][0][(j - 1) & 3][n] : gp, gC = acc[j >> 2][0][j & 3][n], gN = j < 7 ? acc[(j + 1) >> 2][0][(j + 1) & 3][n] : gn;
                const f32x4 vP = j ? acc[(j - 1) >> 2][1][(j - 1) & 3][n] : vp, vC = acc[j >> 2][1][j & 3][n], vN = j < 7 ? acc[(j + 1) >> 2][1][(j + 1) & 3][n] : vn;
                const f32x4 cg_ = bg + w0g * gP + w1g * gC + w2g * gN, cv_ = bv + w0v * vP + w1v * vC + w2v * vN;
                f32x4 o;
#pragma unroll
                for (int e = 0; e < 4; ++e) o[e] = silu_f(cg_[e]) * cv_[e];
                u32x2 w; w.x = pk2(o[0], o[1]); w.y = pk2(o[2], o[3]);
                *(u32x2*)(act + (size_t)(tok0 + j) * DFF + u.pn * 128 + cl) = w;
            }
            asm volatile("" ::: "memory");
        }
    }
};
#include <cstdlib>
#include <vector>

#define XB_TMO      128
#define XB_XCNT(j)  (256  + 64 * (j))
#define XB_XSUB(j)  (1280 + 64 * (j))
#define XB_XGEN(j)  (2304 + 64 * (j))
#define XB_TOP      3328
#define XB_TOPGEN   3392
#define XCD_BAR_WORDS 3456
#define XB_SPIN_CAP (1u << 18)

__device__ __forceinline__ unsigned xb_ld(unsigned* p)              { return __hip_atomic_load(p, __ATOMIC_RELAXED, __HIP_MEMORY_SCOPE_AGENT); }
__device__ __forceinline__ unsigned xb_add(unsigned* p, unsigned v) { return __hip_atomic_fetch_add(p, v, __ATOMIC_RELAXED, __HIP_MEMORY_SCOPE_AGENT); }
__device__ __forceinline__ unsigned xb_xcc_id() { return (unsigned)__builtin_amdgcn_s_getreg((3 << 11) | 20) & 0xFu; }
#define XB_SPIN(cond, bar) do { unsigned _sp = 0; while (cond) { __builtin_amdgcn_s_sleep(1); \
    if ((++_sp & 255u) == 0u) { if (xb_ld(&(bar)[XB_TMO])) break; if (_sp > XB_SPIN_CAP) { atomicAdd(&(bar)[XB_TMO], 1u); break; } } } } while (0)

struct XcdBarrier {
    unsigned* bar; unsigned x;
    volatile PG8_LAS unsigned* st;
};

__device__ __forceinline__ XcdBarrier xcd_barrier_post(unsigned* bar, volatile PG8_LAS unsigned* st) {
    XcdBarrier b; b.bar = bar; b.x = xb_xcc_id(); b.st = st;
    if (threadIdx.x == 0) (void)xb_add(&bar[XB_XCNT(b.x)], 1u);
    return b;
}
__device__ __forceinline__ void xcd_barrier_complete(unsigned* bar, unsigned x, unsigned& nloc, unsigned& nx) {
    const unsigned G = gridDim.x * gridDim.y * gridDim.z;
    unsigned sum, cnt, mine, sp = 0u;
    for (;;) {
        sum = 0u; cnt = 0u; mine = 0u;
#pragma unroll
        for (unsigned j = 0; j < 16; ++j) { const unsigned c = xb_ld(&bar[XB_XCNT(j)]); sum += c; cnt += (c > 0u) ? 1u : 0u; mine = (j == x) ? c : mine; }
        if (sum == G) break;
        __builtin_amdgcn_s_sleep(1);
        if ((++sp & 255u) == 0u) { if (xb_ld(&bar[XB_TMO])) break; if (sp > XB_SPIN_CAP) { atomicAdd(&bar[XB_TMO], 1u); break; } }
    }
    nloc = mine > 0u ? mine : 1u; nx = cnt > 0u ? cnt : 1u;
}

__device__ __forceinline__ void xcd_barrier(const XcdBarrier& b) {
    asm volatile("s_waitcnt vmcnt(0)" ::: "memory");
    __syncthreads();
    if (threadIdx.x == 0) {
        unsigned* bar = b.bar;
        __builtin_amdgcn_s_waitcnt(0);
        unsigned nloc = b.st[0], nx = b.st[1];
        if (nloc == 0u) { xcd_barrier_complete(bar, b.x, nloc, nx); b.st[0] = nloc; b.st[1] = nx; }
        const unsigned old = xb_add(&bar[XB_XSUB(b.x)], 1u);
        const unsigned gen = old / nloc;
        if (old + 1u == (gen + 1u) * nloc) {
            __builtin_amdgcn_fence(__ATOMIC_RELEASE, "agent");
            asm volatile("s_waitcnt vmcnt(0)" ::: "memory");
            const unsigned og = xb_add(&bar[XB_TOP], 1u);
            const unsigned tg = og / nx;
            if (og + 1u == (tg + 1u) * nx) xb_add(&bar[XB_TOPGEN], 1u);
            else XB_SPIN(xb_ld(&bar[XB_TOPGEN]) == tg, bar);
            __builtin_amdgcn_fence(__ATOMIC_ACQUIRE, "agent");
            xb_add(&bar[XB_XGEN(b.x)], 1u);
            asm volatile("s_waitcnt vmcnt(0)" ::: "memory");
        } else {
            XB_SPIN(xb_ld(&bar[XB_XGEN(b.x)]) == gen, bar);
            __builtin_amdgcn_fence(__ATOMIC_ACQUIRE, "agent");
            asm volatile("s_waitcnt vmcnt(0)" ::: "memory");
        }
    }
    __syncthreads();
}
DI void conv_tile(const float* __restrict__ W, int N, int k0, int srcc0, bf16_t* __restrict__ Wt, int K, int dstn0, LP lds, int tid) {
    PG8_LAS float* tile = (PG8_LAS float*)lds;
#pragma unroll
    for (int i = 0; i < 4; ++i) { const int k = (tid >> 4) + 32 * i, n4 = (tid & 15) * 4;
        const f32x4 v = *(const f32x4*)(W + (size_t)(k0 + k) * N + srcc0 + n4);
        tile[k * 65 + n4 + 0] = v[0]; tile[k * 65 + n4 + 1] = v[1]; tile[k * 65 + n4 + 2] = v[2]; tile[k * 65 + n4 + 3] = v[3]; }
    __syncthreads();
    const int n = tid >> 3, ks = (tid & 7) * 16;
    u32x4 o0, o1;
    o0.x = pk2(tile[(ks + 0) * 65 + n], tile[(ks + 1) * 65 + n]); o0.y = pk2(tile[(ks + 2) * 65 + n], tile[(ks + 3) * 65 + n]);
    o0.z = pk2(tile[(ks + 4) * 65 + n], tile[(ks + 5) * 65 + n]); o0.w = pk2(tile[(ks + 6) * 65 + n], tile[(ks + 7) * 65 + n]);
    o1.x = pk2(tile[(ks + 8) * 65 + n], tile[(ks + 9) * 65 + n]); o1.y = pk2(tile[(ks + 10) * 65 + n], tile[(ks + 11) * 65 + n]);
    o1.z = pk2(tile[(ks + 12) * 65 + n], tile[(ks + 13) * 65 + n]); o1.w = pk2(tile[(ks + 14) * 65 + n], tile[(ks + 15) * 65 + n]);
    bf16_t* dp = Wt + (size_t)(dstn0 + n) * K + k0 + ks;
    *(u32x4*)dp = o0; *(u32x4*)(dp + 8) = o1;
    __syncthreads();
}
DI void adaln_item(CP P, int item, LP lds) {
    const int tid = tid_l(); unsigned char* ws = P->ws;
    const int l = item / 96, n0 = (item % 96) * 128;
    PG8_LAS float* s = (PG8_LAS float*)lds;
    { float cv_[36];
#pragma unroll
      for (int q = 0; q < 36; ++q) { const int i = tid + q * NTHR, b = i >> 11, k = i & 2047; cv_[q] = b < 8 ? P->in[I_C][b * D + k] : P->in[I_CCTX][k]; }
#pragma unroll
      for (int q = 0; q < 36; ++q) s[tid + q * NTHR] = silu_f(cv_[q]); }
    __syncthreads();
    const int kg = tid >> 5, cq = tid & 31;
    float acc[9][4];
#pragma unroll
    for (int b = 0; b < 9; ++b)
#pragma unroll
        for (int e = 0; e < 4; ++e) acc[b][e] = 0.f;
    const float* W = P->in[I_WADA] + (size_t)l * D * 6 * D + n0 + 4 * cq;
#pragma unroll 8
    for (int kk = 0; kk < 128; ++kk) { const int k = kg * 128 + kk; const f32x4 w = __builtin_nontemporal_load((const f32x4*)(W + (size_t)k * 6 * D));
#pragma unroll
        for (int b = 0; b < 9; ++b) { const float sv = s[b * D + k];
#pragma unroll
            for (int e = 0; e < 4; ++e) acc[b][e] += sv * w[e]; } }
    __syncthreads();
    PG8_LAS float* red = (PG8_LAS float*)lds;
#pragma unroll
    for (int b = 0; b < 9; ++b)
#pragma unroll
        for (int e = 0; e < 4; ++e) red[(kg * 9 + b) * 128 + 4 * cq + e] = acc[b][e];
    __syncthreads();
    float* mod = (float*)(ws + WS_MOD);
    for (int o = tid; o < 9 * 128; o += NTHR) { const int b = o >> 7, ci = o & 127; float sum = P->in[I_BADA][l * 6 * D + n0 + ci];
        for (int g = 0; g < 16; ++g) sum += red[(g * 9 + b) * 128 + ci];
        mod[((size_t)l * 9 + b) * 6 * D + n0 + ci] = sum; }
    __syncthreads();
}
struct TileDesc { const float* src; bf16_t* dst; int srcN, dstK; };
DI TileDesc tile_desc(CP P, int T) {
    unsigned char* ws = P->ws; TileDesc d;
    const int l = T / 5504; int t = T % 5504;
    if (t < 768) { const int kt = t / 48, nt = t % 48; d.srcN = INW; d.dstK = D; d.src = P->in[I_WIN] + (size_t)l * D * INW + (size_t)(kt * 128) * INW + nt * 64; d.dst = (bf16_t*)(ws + WS_WIN + l * SZ_WIN) + (size_t)(nt * 64) * D + kt * 128; return d; }
    t -= 768;
    if (t < 512) { const int kt = t / 32, nt = t % 32; d.srcN = D; d.dstK = D; d.src = P->in[I_WOUT] + (size_t)l * D * D + (size_t)(kt * 128) * D + nt * 64; d.dst = (bf16_t*)(ws + WS_WOUT + l * SZ_WOUT) + (size_t)(nt * 64) * D + kt * 128; return d; }
    t -= 512;
    if (t < 2816) { const int kt = t / 176, nt = t % 176; const int np = nt * 64, pn = np >> 8, rem = np & 255; const int srcc = rem < 128 ? 128 * pn + rem : DFF + 128 * pn + rem - 128;
        d.srcN = NUP; d.dstK = D; d.src = P->in[I_WUP] + (size_t)l * D * NUP + (size_t)(kt * 128) * NUP + srcc; d.dst = (bf16_t*)(ws + WS_WUP + l * SZ_WUP) + (size_t)np * D + kt * 128; return d; }
    t -= 2816;
    { const int kt = t / 32, nt = t % 32; d.srcN = D; d.dstK = DFF; d.src = P->in[I_WDOWN] + (size_t)l * DFF * D + (size_t)(kt * 128) * D + nt * 64; d.dst = (bf16_t*)(ws + WS_WDN + l * SZ_WDN) + (size_t)(nt * 64) * DFF + kt * 128; return d; }
}
constexpr int FILL_PER = 12, FILL_TILES = 2 * 160 * FILL_PER;
DI int prep_tile_index(int bid, int G, int k) {
    if (G != 256) { const int T = bid + G * k; return T < 11008 ? T : -1; }
    if (bid >= 192) { if (k < 10) return (bid - 192) + 64 * k; k -= 10; }
    const int T = 640 + bid + 256 * k; return T < 5248 ? T : -1;
}
DI void convert_tiles_lin(CP P, LP lds, int Tbase, int stride, int count) {
    const int tid = tid_l();
    PG8_LAS float* tile = (PG8_LAS float*)lds;
    const int lk = tid >> 4, ln4 = (tid & 15) * 4, on = tid >> 3, oks = (tid & 7) * 16;
    f32x4 c0[4], c1[4]; TileDesc d0, d1;
    if (count > 0) { d0 = tile_desc(P, Tbase);
#pragma unroll
        for (int i = 0; i < 4; ++i) c0[i] = *(const f32x4*)(d0.src + (size_t)(lk + 32 * i) * d0.srcN + ln4); }
    if (count > 1) { d1 = tile_desc(P, Tbase + stride);
#pragma unroll
        for (int i = 0; i < 4; ++i) c1[i] = *(const f32x4*)(d1.src + (size_t)(lk + 32 * i) * d1.srcN + ln4); }
    for (int k = 0; k < count; ++k) {
        f32x4 c2[4]; TileDesc d2;
        if (k + 2 < count) { d2 = tile_desc(P, Tbase + (k + 2) * stride);
#pragma unroll
            for (int i = 0; i < 4; ++i) c2[i] = *(const f32x4*)(d2.src + (size_t)(lk + 32 * i) * d2.srcN + ln4); }
#pragma unroll
        for (int i = 0; i < 4; ++i) { const int kk = lk + 32 * i; tile[kk * 65 + ln4 + 0] = c0[i][0]; tile[kk * 65 + ln4 + 1] = c0[i][1]; tile[kk * 65 + ln4 + 2] = c0[i][2]; tile[kk * 65 + ln4 + 3] = c0[i][3]; }
        __syncthreads();
        u32x4 o0, o1;
        o0.x = pk2(tile[(oks + 0) * 65 + on], tile[(oks + 1) * 65 + on]); o0.y = pk2(tile[(oks + 2) * 65 + on], tile[(oks + 3) * 65 + on]);
        o0.z = pk2(tile[(oks + 4) * 65 + on], tile[(oks + 5) * 65 + on]); o0.w = pk2(tile[(oks + 6) * 65 + on], tile[(oks + 7) * 65 + on]);
        o1.x = pk2(tile[(oks + 8) * 65 + on], tile[(oks + 9) * 65 + on]); o1.y = pk2(tile[(oks + 10) * 65 + on], tile[(oks + 11) * 65 + on]);
        o1.z = pk2(tile[(oks + 12) * 65 + on], tile[(oks + 13) * 65 + on]); o1.w = pk2(tile[(oks + 14) * 65 + on], tile[(oks + 15) * 65 + on]);
        bf16_t* dp = d0.dst + (size_t)on * d0.dstK + oks;
        *(u32x4*)dp = o0; *(u32x4*)(dp + 8) = o1;
        __syncthreads();
        d0 = d1; d1 = d2;
#pragma unroll
        for (int i = 0; i < 4; ++i) { c0[i] = c1[i]; c1[i] = c2[i]; }
    }
}
DI void filler_phase(CP P, int slot, LP lds) {
    const int bid = bid_l();
    if (gridDim.x != 256) return;
    if (slot < 2) { if (bid >= 96) convert_tiles_lin(P, lds, 6016 + slot * 1920 + (bid - 96), 160, 12); }
    else if (slot == 2) { if (bid >= 64) convert_tiles_lin(P, lds, 5248 + (bid - 64), 192, 4); }
    else { if (bid >= 64) convert_tiles_lin(P, lds, 9856 + (bid - 64), 192, 6); }
}
DI void prep_phase(CP P, LP lds) {
    const int tid = tid_l(), bid = bid_l(), G = gridDim.x;
    for (int item = bid; item < 192; item += G) adaln_item(P, item, lds);
    if (bid == G - 1) { float* tab = (float*)(P->ws + WS_ROPE);
        for (int i = tid; i < 64 * 32; i += NTHR) { const int pos = i >> 5, f = i & 31; const float inv = 1.0f / powf(10000.0f, (float)(2 * f) / 64.0f); const float ang = (float)pos * inv;
            tab[2 * i] = cosf(ang); tab[2 * i + 1] = sinf(ang); } }
    PG8_LAS float* tile = (PG8_LAS float*)lds;
    const int lk = tid >> 4, ln4 = (tid & 15) * 4, on = tid >> 3, oks = (tid & 7) * 16;
    int T0 = prep_tile_index(bid, G, 0), T1 = T0 >= 0 ? prep_tile_index(bid, G, 1) : -1;
    f32x4 c0[4], c1[4]; TileDesc d0, d1;
    if (T0 >= 0) { d0 = tile_desc(P, T0);
#pragma unroll
        for (int i = 0; i < 4; ++i) c0[i] = *(const f32x4*)(d0.src + (size_t)(lk + 32 * i) * d0.srcN + ln4); }
    if (T1 >= 0) { d1 = tile_desc(P, T1);
#pragma unroll
        for (int i = 0; i < 4; ++i) c1[i] = *(const f32x4*)(d1.src + (size_t)(lk + 32 * i) * d1.srcN + ln4); }
    for (int k = 0; T0 >= 0; ++k) {
        const int T2 = T1 >= 0 ? prep_tile_index(bid, G, k + 2) : -1;
        f32x4 c2[4]; TileDesc d2;
        if (T2 >= 0) { d2 = tile_desc(P, T2);
#pragma unroll
            for (int i = 0; i < 4; ++i) c2[i] = *(const f32x4*)(d2.src + (size_t)(lk + 32 * i) * d2.srcN + ln4); }
#pragma unroll
        for (int i = 0; i < 4; ++i) { const int kk = lk + 32 * i; tile[kk * 65 + ln4 + 0] = c0[i][0]; tile[kk * 65 + ln4 + 1] = c0[i][1]; tile[kk * 65 + ln4 + 2] = c0[i][2]; tile[kk * 65 + ln4 + 3] = c0[i][3]; }
        __syncthreads();
        u32x4 o0, o1;
        o0.x = pk2(tile[(oks + 0) * 65 + on], tile[(oks + 1) * 65 + on]); o0.y = pk2(tile[(oks + 2) * 65 + on], tile[(oks + 3) * 65 + on]);
        o0.z = pk2(tile[(oks + 4) * 65 + on], tile[(oks + 5) * 65 + on]); o0.w = pk2(tile[(oks + 6) * 65 + on], tile[(oks + 7) * 65 + on]);
        o1.x = pk2(tile[(oks + 8) * 65 + on], tile[(oks + 9) * 65 + on]); o1.y = pk2(tile[(oks + 10) * 65 + on], tile[(oks + 11) * 65 + on]);
        o1.z = pk2(tile[(oks + 12) * 65 + on], tile[(oks + 13) * 65 + on]); o1.w = pk2(tile[(oks + 14) * 65 + on], tile[(oks + 15) * 65 + on]);
        bf16_t* dp = d0.dst + (size_t)on * d0.dstK + oks;
        *(u32x4*)dp = o0; *(u32x4*)(dp + 8) = o1;
        __syncthreads();
        T0 = T1; T1 = T2; d0 = d1; d1 = d2;
#pragma unroll
        for (int i = 0; i < 4; ++i) { c0[i] = c1[i]; c1[i] = c2[i]; }
    }
}
DI void norm_mod_phase(CP P, int l, int which, int nrows, LP lds) {
    const int tid = tid_l(), lane = tid & 63, wave = tid >> 6, gw = bid_l() * 8 + wave, nw = gridDim.x * 8;
    unsigned char* ws = P->ws; float* X = (float*)(ws + WS_X); bf16_t* H = (bf16_t*)(ws + WS_H);
    const bool fin = (gridDim.x == 256) && ((l == 0 && which == 1) || (l == 1 && which == 0));
    PG8_LAS int* tbl = (PG8_LAS int*)lds;
    if (fin) { for (int i = tid; i < 576; i += NTHR) tbl[i] = -1;
        __syncthreads();
        if (tid < 64) { pg8::StaticOrder S; S.init(MT, D, 256, tid); Unit u; if (S.next(2, u)) tbl[u.pm * 8 + u.pn] = tid; }
        __syncthreads(); }
    const float* XPp = (const float*)(ws + WS_XP);
    const float* g = (which ? P->in[I_N2G] : P->in[I_N1G]) + l * D;
#define NM_XROW(r_) ((l == 0 && which == 0) ? ((r_) < NLAT ? P->in[I_X] + (size_t)(r_) * D : P->in[I_CTX] + (size_t)((r_) - NLAT) * D) : X + (size_t)(r_) * D)
    const int rpw = (nrows + nw - 1) / nw, r0 = gw * rpw, r1 = (r0 + rpw) < nrows ? (r0 + rpw) : nrows;
    f32x4 v[8], ga[8], gb[8]; int bcur = -1;
    if (r0 < r1) { const float* xr0 = NM_XROW(r0);
#pragma unroll
        for (int i = 0; i < 8; ++i) v[i] = *(const f32x4*)(xr0 + 4 * lane + 256 * i); }
    for (int r = r0; r < r1; ++r) {
        const int rn = r + 1; f32x4 vn[8];
        if (rn < r1) { const float* xrn = NM_XROW(rn);
#pragma unroll
            for (int i = 0; i < 8; ++i) vn[i] = *(const f32x4*)(xrn + 4 * lane + 256 * i); }
        const int b = r < NLAT ? (r >> 11) : 8;
        if (b != bcur) { bcur = b;
            const float* sh = (const float*)(ws + WS_MOD) + (((size_t)l * 9 + b) * 6 + (which ? 3 : 0)) * D; const float* sc = sh + D;
#pragma unroll
            for (int i = 0; i < 8; ++i) { const int col = 4 * lane + 256 * i; ga[i] = *(const f32x4*)(g + col) * (1.0f + *(const f32x4*)(sc + col)); gb[i] = *(const f32x4*)(sh + col); } }
        float ss = 0.f;
#pragma unroll
        for (int i = 0; i < 8; ++i) {
            if (fin) { const int t = tbl[(r >> 8) * 8 + i];
                if (t >= 0) { const float* xp = XPp + ((size_t)(t * 3) << 16) + (size_t)(r & 255) * 256 + 4 * lane;
                    v[i] += *(const f32x4*)xp + *(const f32x4*)(xp + 65536) + *(const f32x4*)(xp + 131072);
                    *(f32x4*)(X + (size_t)r * D + 4 * lane + 256 * i) = v[i]; } }
            ss += v[i][0] * v[i][0] + v[i][1] * v[i][1] + v[i][2] * v[i][2] + v[i][3] * v[i][3]; }
#pragma unroll
        for (int o = 32; o >= 1; o >>= 1) ss += __shfl_xor(ss, o);
        const float rstd = rsqrtf(ss * (1.0f / D) + EPS);
        if (which == 0 && lane == 0) ((float*)(ws + WS_SSQ))[r] = 0.f;
#pragma unroll
        for (int i = 0; i < 8; ++i) { const int col = 4 * lane + 256 * i;
            const f32x4 h = v[i] * rstd * ga[i] + gb[i]; u32x2 w; w.x = pk2(h[0], h[1]); w.y = pk2(h[2], h[3]);
            *(u32x2*)(H + (size_t)r * D + col) = w; }
#pragma unroll
        for (int i = 0; i < 8; ++i) v[i] = vn[i];
    }
#undef NM_XROW
}
DI void final_norm_phase(CP P) {
    const int tid = tid_l(), lane = tid & 63, wave = tid >> 6, gw = bid_l() * 8 + wave, nw = gridDim.x * 8;
    const float* X = (const float*)(P->ws + WS_X); const float* g = P->in[I_FNG];
    const int rpw = (NLAT + nw - 1) / nw, r0 = gw * rpw, r1 = (r0 + rpw) < NLAT ? (r0 + rpw) : NLAT;
    f32x4 v[8], gg[8];
#pragma unroll
    for (int i = 0; i < 8; ++i) gg[i] = *(const f32x4*)(g + 4 * lane + 256 * i);
    if (r0 < r1) {
#pragma unroll
        for (int i = 0; i < 8; ++i) v[i] = *(const f32x4*)(X + (size_t)r0 * D + 4 * lane + 256 * i); }
    for (int r = r0; r < r1; ++r) {
        const int rn = r + 1; f32x4 vn[8];
        if (rn < r1) {
#pragma unroll
            for (int i = 0; i < 8; ++i) vn[i] = *(const f32x4*)(X + (size_t)rn * D + 4 * lane + 256 * i); }
        float ss = 0.f;
#pragma unroll
        for (int i = 0; i < 8; ++i) ss += v[i][0] * v[i][0] + v[i][1] * v[i][1] + v[i][2] * v[i][2] + v[i][3] * v[i][3];
#pragma unroll
        for (int o = 32; o >= 1; o >>= 1) ss += __shfl_xor(ss, o);
        const float rstd = rsqrtf(ss * (1.0f / D) + EPS);
#pragma unroll
        for (int i = 0; i < 8; ++i) *(f32x4*)(P->out + (size_t)r * D + 4 * lane + 256 * i) = v[i] * rstd * gg[i];
#pragma unroll
        for (int i = 0; i < 8; ++i) v[i] = vn[i];
    }
}
DI void qk_phase(CP P, int l) {
    const int tid = tid_l(), lane = tid & 63, wave = tid >> 6, j = lane & 15, grp = lane >> 4;
    unsigned char* ws = P->ws; bf16_t* Pb = (bf16_t*)(ws + WS_P); const float* tab = (const float*)(ws + WS_ROPE);
    const int nrows = MT, nw = gridDim.x * 8;
    float qg[8], kg[8];
#pragma unroll
    for (int e = 0; e < 8; ++e) { qg[e] = P->in[I_QNG][l * 128 + 8 * j + e] * QSCALE; kg[e] = P->in[I_KNG][l * 128 + 8 * j + e]; }
    const bool first = (j & 4) == 0;
    for (int row = bid_l() * 8 + wave; row < nrows; row += nw) {
        const bool lat = row < NLAT; const bool qrow = lat || l == 0;
        float cs[8], sn[8];
        if (lat) { const int t = row & 2047, pos = (j & 8) ? (t & 63) : (t >> 6); const float* tp = tab + (size_t)(pos * 32 + 8 * (j & 3)) * 2;
            const f32x4 t0 = *(const f32x4*)tp, t1 = *(const f32x4*)(tp + 4), t2 = *(const f32x4*)(tp + 8), t3 = *(const f32x4*)(tp + 12);
            cs[0] = t0[0]; sn[0] = t0[1]; cs[1] = t0[2]; sn[1] = t0[3]; cs[2] = t1[0]; sn[2] = t1[1]; cs[3] = t1[2]; sn[3] = t1[3];
            cs[4] = t2[0]; sn[4] = t2[1]; cs[5] = t2[2]; sn[5] = t2[3]; cs[6] = t3[0]; sn[6] = t3[1]; cs[7] = t3[2]; sn[7] = t3[3]; }
        else {
#pragma unroll
            for (int e = 0; e < 8; ++e) { cs[e] = 1.f; sn[e] = 0.f; } }
        bf16_t* rp = Pb + (size_t)row * INW + 8 * j;
        u32x4 raw[3]; const bool kact = grp < 2;
        if (qrow) { raw[0] = *(const u32x4*)(rp + grp * 128); raw[1] = *(const u32x4*)(rp + (4 + grp) * 128); }
        const bool kpart = (l == 1 && !lat);
        float kx[8];
        if (kpart) { if (kact) { const float* kp = (const float*)(ws + WS_KVP) + (size_t)(row - NLAT) * 512 + grp * 128 + 8 * j;
                f32x4 a0 = *(const f32x4*)kp, a1 = *(const f32x4*)(kp + 4);
#pragma unroll
                for (int q = 1; q < 4; ++q) { a0 += *(const f32x4*)(kp + (size_t)q * NCTX * 512); a1 += *(const f32x4*)(kp + (size_t)q * NCTX * 512 + 4); }
                kx[0] = a0[0]; kx[1] = a0[1]; kx[2] = a0[2]; kx[3] = a0[3]; kx[4] = a1[0]; kx[5] = a1[1]; kx[6] = a1[2]; kx[7] = a1[3]; }
            else {
#pragma unroll
                for (int e = 0; e < 8; ++e) kx[e] = 0.f; } }
        else raw[2] = *(const u32x4*)(rp + 1024 + (kact ? grp : 0) * 128);
#pragma unroll
        for (int pass = 0; pass < 3; ++pass) {
            if (pass < 2 && !qrow) continue;
            float x[8];
            if (pass == 2 && kpart) {
#pragma unroll
                for (int e = 0; e < 8; ++e) x[e] = kx[e]; }
            else { const u32x4 rw = raw[pass]; x[0] = bf_lo(rw.x); x[1] = bf_hi(rw.x); x[2] = bf_lo(rw.y); x[3] = bf_hi(rw.y); x[4] = bf_lo(rw.z); x[5] = bf_hi(rw.z); x[6] = bf_lo(rw.w); x[7] = bf_hi(rw.w); }
            float ss = 0.f;
#pragma unroll
            for (int e = 0; e < 8; ++e) ss += x[e] * x[e];
            ss += __shfl_xor(ss, 1); ss += __shfl_xor(ss, 2); ss += __shfl_xor(ss, 4); ss += __shfl_xor(ss, 8);
            const float rstd = rsqrtf(ss * (1.0f / 128.0f) + EPS);
            float y[8], yp[8];
#pragma unroll
            for (int e = 0; e < 8; ++e) y[e] = x[e] * rstd * (pass < 2 ? qg[e] : kg[e]);
#pragma unroll
            for (int e = 0; e < 8; ++e) yp[e] = __shfl_xor(y[e], 4);
#pragma unroll
            for (int e = 0; e < 8; ++e) y[e] = first ? (y[e] * cs[e] - yp[e] * sn[e]) : (y[e] * cs[e] + yp[e] * sn[e]);
            u32x4 w; w.x = pk2(y[0], y[1]); w.y = pk2(y[2], y[3]); w.z = pk2(y[4], y[5]); w.w = pk2(y[6], y[7]);
            if (pass == 0) *(u32x4*)(rp + grp * 128) = w;
            else if (pass == 1) *(u32x4*)(rp + (4 + grp) * 128) = w;
            else if (kact) *(u32x4*)(rp + 1024 + grp * 128) = w;
        }
    }
}
DI void vt_phase(CP P, int l, LP lds) {
    const int tid = tid_l(); unsigned char* ws = P->ws; const bf16_t* Pb = (const bf16_t*)(ws + WS_P);
    for (int it = (bid_l() + (int)((gridDim.x * 3) >> 2)) % (int)gridDim.x; it < 288; it += gridDim.x) {
        int rowbase, LV, t0, b; bf16_t* dst;
        if (it < 256) { b = it >> 5; t0 = (it & 31) * 64; rowbase = b * SEQ + t0; LV = SEQ; dst = (bf16_t*)(ws + WS_VTL) + (size_t)b * 2 * 128 * SEQ + t0; }
        else { const int i2 = it - 256; b = i2 >> 2; t0 = (i2 & 3) * 64; rowbase = NLAT + b * CTXL + t0; LV = CTXL; dst = (bf16_t*)(ws + WS_VTC) + (size_t)b * 2 * 128 * CTXL + t0; }
#pragma unroll
        for (int i = 0; i < 4; ++i) { const int idx = tid + 512 * i, row = idx >> 5, c16 = idx & 31;
            u32x4 v;
            if (l == 1 && it >= 256) {
                const float* vp = (const float*)(ws + WS_KVP) + (size_t)(rowbase - NLAT + row) * 512 + 256 + 8 * c16;
                f32x4 a0 = *(const f32x4*)vp, a1 = *(const f32x4*)(vp + 4);
#pragma unroll
                for (int q = 1; q < 4; ++q) { a0 += *(const f32x4*)(vp + (size_t)q * NCTX * 512); a1 += *(const f32x4*)(vp + (size_t)q * NCTX * 512 + 4); }
                v.x = pk2(a0[0], a0[1]); v.y = pk2(a0[2], a0[3]); v.z = pk2(a1[0], a1[1]); v.w = pk2(a1[2], a1[3]);
            } else v = *(const u32x4*)(Pb + (size_t)(rowbase + row) * INW + 1280 + 8 * c16);
            *(PG8_LAS u32x4*)(lds + row * 528 + c16 * 16) = v; }
        __syncthreads();
#pragma unroll
        for (int i = 0; i < 4; ++i) { const int idx = tid + 512 * i, col = idx >> 3, ts = idx & 7;
            unsigned short e[8];
#pragma unroll
            for (int k = 0; k < 8; ++k) e[k] = *(const PG8_LAS unsigned short*)(lds + (8 * ts + k) * 528 + col * 2);
            u32x4 w; w.x = e[0] | ((unsigned)e[1] << 16); w.y = e[2] | ((unsigned)e[3] << 16); w.z = e[4] | ((unsigned)e[5] << 16); w.w = e[6] | ((unsigned)e[7] << 16);
            *(u32x4*)(dst + (size_t)col * LV + 8 * ts) = w; }
        __syncthreads();
    }
}
#define MFMA16(a, b, c) __builtin_amdgcn_mfma_f32_16x16x32_bf16((a), (b), (c), 0, 0, 0)
#define MFMA32(a, b, c) __builtin_amdgcn_mfma_f32_32x32x16_bf16((a), (b), (c), 0, 0, 0)
DI void pool_phase(CP P, int l, LP lds) {
    const int tid = tid_l(), lane = tid & 63, wave = tid >> 6; unsigned char* ws = P->ws;
    const bf16_t* Pb = (const bf16_t*)(ws + WS_P); bf16_t* MIX = (bf16_t*)(ws + WS_MIX);
    const LP raw = lds, Yl = lds + 144 * 272, Wt = lds + 144 * 272 + 128 * 272;
    const int nitems = (l == 0 ? 144 : 128) * 4; int wgi = -1;
    for (int it = bid_l(); it < nitems; it += gridDim.x) {
        const int gi = it & 3, tile = it >> 2, row0 = tile * 128;
        const int L = row0 < NLAT ? SEQ : CTXL, s0 = row0 < NLAT ? (row0 & ~(SEQ - 1)) : NLAT + ((row0 - NLAT) & ~(CTXL - 1)), tpos0 = row0 - s0;
        const int w = 2 << gi;
        { u32x4 rv_[5]; bool ok_[5];
#pragma unroll
          for (int q = 0; q < 5; ++q) { const int i = tid + q * NTHR, rr = i >> 4, c = i & 15, tp = tpos0 - 8 + rr; ok_[q] = (i < 144 * 16) && tp >= 0 && tp < L;
              if (ok_[q]) rv_[q] = *(const u32x4*)(Pb + (size_t)(s0 + tp) * INW + 1536 + gi * 128 + c * 8); }
#pragma unroll
          for (int q = 0; q < 5; ++q) { const int i = tid + q * NTHR, rr = i >> 4, c = i & 15; if (ok_[q]) *(PG8_LAS u32x4*)(raw + rr * 272 + c * 16) = rv_[q]; } }
        if (gi != wgi) { wgi = gi;
            const float* pw = P->in[I_POOLW] + ((size_t)l * 4 + gi) * 128 * 128;
            f32x4 wv_[8];
#pragma unroll
            for (int q = 0; q < 8; ++q) { const int i = tid + q * NTHR; wv_[q] = *(const f32x4*)(pw + (i >> 5) * 128 + (i & 31) * 4); }
#pragma unroll
            for (int q = 0; q < 8; ++q) { const int i = tid + q * NTHR, c = i >> 5, d4 = (i & 31) * 4;
#pragma unroll
                for (int e = 0; e < 4; ++e) *(PG8_LAS unsigned short*)(Wt + (d4 + e) * 272 + c * 2) = (unsigned short)(pk2(wv_[q][e], 0.f) & 0xffffu); } }
        __syncthreads();
        { const int t = tid >> 2, cs = (tid & 3) * 32, tp = tpos0 + t;
          int lo = tp - (w >> 1), hi = lo + w; lo = lo < 0 ? 0 : lo; hi = hi > L ? L : hi; const float inv = 1.0f / (float)(hi - lo);
#pragma unroll
          for (int q = 0; q < 4; ++q) { float sum[8];
#pragma unroll
              for (int e = 0; e < 8; ++e) sum[e] = 0.f;
              for (int tt = lo; tt < hi; ++tt) { const u32x4 v = *(const PG8_LAS u32x4*)(raw + (tt - tpos0 + 8) * 272 + (cs + 8 * q) * 2);
                  sum[0] += bf_lo(v.x); sum[1] += bf_hi(v.x); sum[2] += bf_lo(v.y); sum[3] += bf_hi(v.y); sum[4] += bf_lo(v.z); sum[5] += bf_hi(v.z); sum[6] += bf_lo(v.w); sum[7] += bf_hi(v.w); }
              const u32x4 sv = *(const PG8_LAS u32x4*)(raw + (t + 8) * 272 + (cs + 8 * q) * 2);
              u32x4 o; o.x = pk2(sum[0] * inv - bf_lo(sv.x), sum[1] * inv - bf_hi(sv.x)); o.y = pk2(sum[2] * inv - bf_lo(sv.y), sum[3] * inv - bf_hi(sv.y));
              o.z = pk2(sum[4] * inv - bf_lo(sv.z), sum[5] * inv - bf_hi(sv.z)); o.w = pk2(sum[6] * inv - bf_lo(sv.w), sum[7] * inv - bf_hi(sv.w));
              *(PG8_LAS u32x4*)(Yl + t * 272 + (cs + 8 * q) * 2) = o; } }
        __syncthreads();
        { f32x4 acc[8];
#pragma unroll
          for (int dt = 0; dt < 8; ++dt) acc[dt] = (f32x4){0.f, 0.f, 0.f, 0.f};
          const int li = lane & 15, lq = lane >> 4;
#pragma unroll
          for (int ks = 0; ks < 4; ++ks) { const bf16x8 bfr = *(const PG8_LAS bf16x8*)(Yl + (16 * wave + li) * 272 + (32 * ks + 8 * lq) * 2);
#pragma unroll
              for (int dt = 0; dt < 8; ++dt) { const bf16x8 afr = *(const PG8_LAS bf16x8*)(Wt + (16 * dt + li) * 272 + (32 * ks + 8 * lq) * 2); acc[dt] = MFMA16(afr, bfr, acc[dt]); } }
          const int token = row0 + 16 * wave + li; const float* psc = P->in[I_POOLS] + l * 512 + gi * 128 + 4 * lq;
          f32x4 sc_[8];
#pragma unroll
          for (int dt = 0; dt < 8; ++dt) sc_[dt] = *(const f32x4*)(psc + 16 * dt);
#pragma unroll
          for (int dt = 0; dt < 8; ++dt) { const f32x4 o = acc[dt] * sc_[dt]; u32x2 wv; wv.x = pk2(o[0], o[1]); wv.y = pk2(o[2], o[3]);
              *(u32x2*)(MIX + (size_t)token * D + 1024 + gi * 128 + 16 * dt + 4 * lq) = wv; } }
        __syncthreads();
    }
}
DI void sgu_phase(CP P, int l, LP lds) {
    const int tid = tid_l(), lane = tid & 63, wave = tid >> 6; unsigned char* ws = P->ws;
    const bf16_t* Pb = (const bf16_t*)(ws + WS_P); bf16_t* MIX = (bf16_t*)(ws + WS_MIX);
    const LP Vt = lds, Wl = lds + 128 * 272;
    const int nitems = (l == 0 ? 144 : 128) * 4; int whh = -1;
    for (int it = (bid_l() + (int)(gridDim.x >> 1)) % (int)gridDim.x; it < nitems; it += gridDim.x) {
        const int hh = it & 3, chunk = it >> 2, row0 = chunk * 128;
        const int q = tid >> 2, part = tid & 3;
        const bf16_t* gr = Pb + (size_t)(row0 + q) * INW + 2560;
        const float ss = ((const float*)(ws + WS_SSQ))[row0 + q];
        const float rstd = rsqrtf(ss * (1.0f / 512.0f) + EPS);
        const float* gn = P->in[I_SGUNG] + l * 512 + hh * 128 + part * 32;
#pragma unroll
        for (int i = 0; i < 4; ++i) { const u32x4 v = *(const u32x4*)(gr + hh * 128 + part * 32 + 8 * i);
            const f32x4 a = (f32x4){bf_lo(v.x), bf_hi(v.x), bf_lo(v.y), bf_hi(v.y)}, b = (f32x4){bf_lo(v.z), bf_hi(v.z), bf_lo(v.w), bf_hi(v.w)};
            const f32x4 g0 = *(const f32x4*)(gn + 8 * i), g1 = *(const f32x4*)(gn + 8 * i + 4);
            const int c0 = part * 32 + 8 * i;
#pragma unroll
            for (int e = 0; e < 4; ++e) { *(PG8_LAS unsigned short*)(Vt + (c0 + e) * 272 + q * 2) = (unsigned short)(pk2(a[e] * rstd * g0[e], 0.f) & 0xffffu);
                                          *(PG8_LAS unsigned short*)(Vt + (c0 + 4 + e) * 272 + q * 2) = (unsigned short)(pk2(b[e] * rstd * g1[e], 0.f) & 0xffffu); } }
        if (hh != whh) { whh = hh;
            const float* sw = P->in[I_SGUW] + ((size_t)l * 4 + hh) * 128 * 128;
            f32x4 wv_[8];
#pragma unroll
            for (int q = 0; q < 8; ++q) { const int i = tid + q * NTHR; wv_[q] = *(const f32x4*)(sw + (i >> 5) * 128 + (i & 31) * 4); }
#pragma unroll
            for (int q = 0; q < 8; ++q) { const int i = tid + q * NTHR, pp = i >> 5, q4 = (i & 31) * 4;
                u32x2 o; o.x = pk2(wv_[q][0], wv_[q][1]); o.y = pk2(wv_[q][2], wv_[q][3]); *(PG8_LAS u32x2*)(Wl + pp * 272 + q4 * 2) = o; } }
        __syncthreads();
        { f32x4 acc[8];
#pragma unroll
          for (int ct = 0; ct < 8; ++ct) acc[ct] = (f32x4){0.f, 0.f, 0.f, 0.f};
          const int li = lane & 15, lq = lane >> 4;
#pragma unroll
          for (int ks = 0; ks < 4; ++ks) { const bf16x8 wfr = *(const PG8_LAS bf16x8*)(Wl + (16 * wave + li) * 272 + (32 * ks + 8 * lq) * 2);
#pragma unroll
              for (int ct = 0; ct < 8; ++ct) { const bf16x8 vfr = *(const PG8_LAS bf16x8*)(Vt + (16 * ct + li) * 272 + (32 * ks + 8 * lq) * 2); acc[ct] = MFMA16(vfr, wfr, acc[ct]); } }
          const int pl = 16 * wave + li, token = row0 + pl; const float bias = P->in[I_SGUB][(l * 4 + hh) * 128 + pl];
          const bf16_t* up = Pb + (size_t)token * INW + 2048 + hh * 128 + 4 * lq;
          u32x2 uv_[8];
#pragma unroll
          for (int ct = 0; ct < 8; ++ct) uv_[ct] = *(const u32x2*)(up + 16 * ct);
#pragma unroll
          for (int ct = 0; ct < 8; ++ct) { const u32x2 uv = uv_[ct]; const f32x4 ug = (f32x4){bf_lo(uv.x), bf_hi(uv.x), bf_lo(uv.y), bf_hi(uv.y)};
              const f32x4 o = ug * (acc[ct] + bias); u32x2 wv; wv.x = pk2(o[0], o[1]); wv.y = pk2(o[2], o[3]);
              *(u32x2*)(MIX + (size_t)token * D + 1536 + hh * 128 + 16 * ct + 4 * lq) = wv; } }
        __syncthreads();
    }
}
DI void attn_phase(CP P, int l, LP lds) {
    const int tid = tid_l(), lane = tid & 63, wave = tid >> 6, r = lane & 31, h = lane >> 5; unsigned char* ws = P->ws;
    const bf16_t* Pb = (const bf16_t*)(ws + WS_P); bf16_t* MIX = (bf16_t*)(ws + WS_MIX);
    const bf16_t* VTL = (const bf16_t*)(ws + WS_VTL); const bf16_t* VTC = (const bf16_t*)(ws + WS_VTC);
    constexpr int ATT_BUF = 64 * 272 + 128 * 144;
    const LP Kl = lds, Vl = lds + 64 * 272;
    const int nitems = l == 0 ? 576 : 512;
    for (int it = bid_l(); it < nitems; it += gridDim.x) {
        const bool isctx = it >= 512; int b, n, kh, hp;
        if (!isctx) { hp = it & 1; kh = (it >> 1) & 1; n = (it >> 2) & 15; b = it >> 6; } else { const int i2 = it - 512; hp = i2 & 1; kh = (i2 >> 1) & 1; n = (i2 >> 2) & 1; b = i2 >> 3; }
        const int qrow0 = isctx ? NLAT + b * CTXL + n * 128 : b * SEQ + n * 128;
        const int hq = kh * 4 + hp * 2 + (wave >> 2), qsub = wave & 3, myrow = qrow0 + qsub * 32 + r;
        bf16x8 qf[8];
#pragma unroll
        for (int ks = 0; ks < 8; ++ks) qf[ks] = *(const bf16x8*)(Pb + (size_t)myrow * INW + hq * 128 + 16 * ks + 8 * h);
        const int kb_lo = n > 0 ? n - 1 : 0, kb_hi = n < 15 ? n + 1 : 15;
        const int nband = isctx ? 0 : (kb_hi - kb_lo + 1) * 2, nch = nband + 4;
        float m = P->in[I_SINK][l * 8 + hq] * LOG2E, lsum = 1.0f;
        f32x16 O[4];
#pragma unroll
        for (int dt = 0; dt < 4; ++dt)
#pragma unroll
            for (int i = 0; i < 16; ++i) O[dt][i] = 0.f;
        u32x4 pre[4];
        const bf16_t* Kc_base = Pb + (size_t)(NLAT + b * CTXL) * INW + 1024 + kh * 128;
        const bf16_t* Kb_base = Pb + (size_t)(b * SEQ) * INW + 1024 + kh * 128;
        const bf16_t* Vc_base = VTC + (size_t)(b * 2 + kh) * 128 * CTXL;
        const bf16_t* Vb_base = VTL + (size_t)(b * 2 + kh) * 128 * SEQ;
#define ATT_LOAD(c) do { const bool band_ = (c) < nband; const int key0_ = band_ ? kb_lo * 128 + (c) * 64 : ((c) - nband) * 64; \
            const bf16_t* kb_ = band_ ? Kb_base : Kc_base; const bf16_t* vb_ = band_ ? Vb_base : Vc_base; const int lv_ = band_ ? SEQ : CTXL; \
            _Pragma("unroll") for (int i_ = 0; i_ < 2; ++i_) { const int p_ = tid + 512 * i_; \
                pre[i_] = *(const u32x4*)(kb_ + (size_t)(key0_ + (p_ >> 4)) * INW + (p_ & 15) * 8); \
                pre[2 + i_] = *(const u32x4*)(vb_ + (size_t)(p_ >> 3) * lv_ + key0_ + (p_ & 7) * 8); } } while (0)
        ATT_LOAD(0);
        __syncthreads();
#pragma unroll
        for (int i = 0; i < 2; ++i) { const int p = tid + 512 * i; *(PG8_LAS u32x4*)(Kl + (p >> 4) * 272 + (p & 15) * 16) = pre[i]; *(PG8_LAS u32x4*)(Vl + (p >> 3) * 144 + (p & 7) * 16) = pre[2 + i]; }
        __syncthreads();
        for (int c = 0; c < nch; ++c) {
            const LP Kc = Kl + (c & 1) * ATT_BUF, Vc = Vl + (c & 1) * ATT_BUF;
            if (c + 1 < nch) ATT_LOAD(c + 1);
            bool skip = false; int kblk = n;
            if (c < nband) { kblk = kb_lo + (c >> 1);
                if (kblk < n) skip = ((c & 1) == 0) && (qsub >= 2);
                else if (kblk > n) skip = ((c & 1) == 1) && (qsub < 2); }
            if (!skip) {
            f32x16 S0, S1;
#pragma unroll
            for (int i = 0; i < 16; ++i) { S0[i] = 0.f; S1[i] = 0.f; }
#pragma unroll
            for (int ks = 0; ks < 8; ++ks) { const bf16x8 k0 = *(const PG8_LAS bf16x8*)(Kc + r * 272 + (16 * ks + 8 * h) * 2), k1 = *(const PG8_LAS bf16x8*)(Kc + (32 + r) * 272 + (16 * ks + 8 * h) * 2);
                S0 = MFMA32(k0, qf[ks], S0); S1 = MFMA32(k1, qf[ks], S1); }
            const bool allvalid = (kblk < n) ? (((c & 1) == 1) && (qsub < 2)) : (((c & 1) == 0) && (qsub >= 2));
            if (kblk != n && !allvalid) { const int qi = n * 128 + qsub * 32 + r, kj0 = kblk * 128 + (c & 1) * 64 + 4 * h;
#pragma unroll
                for (int i = 0; i < 16; ++i) { const int kj = kj0 + (i & 3) + 8 * (i >> 2); int dd = qi - kj; dd = dd < 0 ? -dd : dd;
                    if (dd > 128) S0[i] = -1e30f; int d2 = qi - (kj + 32); d2 = d2 < 0 ? -d2 : d2; if (d2 > 128) S1[i] = -1e30f; } }
            float cmax = S0[0];
#pragma unroll
            for (int i = 1; i < 16; ++i) cmax = fmaxf(cmax, S0[i]);
#pragma unroll
            for (int i = 0; i < 16; ++i) cmax = fmaxf(cmax, S1[i]);
            { const auto r_ = __builtin_amdgcn_permlane32_swap(__float_as_uint(cmax), __float_as_uint(cmax), false, false); cmax = fmaxf(__uint_as_float(r_[0]), __uint_as_float(r_[1])); }
            const bool grew = cmax > m + 8.0f; const float mnew = grew ? cmax : m, alpha = __builtin_amdgcn_exp2f(m - mnew); m = mnew;
            float rs = 0.f;
#pragma unroll
            for (int i = 0; i < 16; ++i) { S0[i] = __builtin_amdgcn_exp2f(S0[i] - mnew); S1[i] = __builtin_amdgcn_exp2f(S1[i] - mnew); rs += S0[i] + S1[i]; }
            { const auto r_ = __builtin_amdgcn_permlane32_swap(__float_as_uint(rs), __float_as_uint(rs), false, false); rs = __uint_as_float(r_[0]) + __uint_as_float(r_[1]); }
            lsum = lsum * alpha + rs;
            if (__any(grew)) {
#pragma unroll
                for (int dt = 0; dt < 4; ++dt)
#pragma unroll
                    for (int i = 0; i < 16; ++i) O[dt][i] *= alpha; }
            bf16x8 pf[2][2];
#pragma unroll
            for (int s = 0; s < 2; ++s) { u32x4 a, bq;
                a.x = pk2(S0[8 * s + 0], S0[8 * s + 1]); a.y = pk2(S0[8 * s + 2], S0[8 * s + 3]); a.z = pk2(S0[8 * s + 4], S0[8 * s + 5]); a.w = pk2(S0[8 * s + 6], S0[8 * s + 7]);
                bq.x = pk2(S1[8 * s + 0], S1[8 * s + 1]); bq.y = pk2(S1[8 * s + 2], S1[8 * s + 3]); bq.z = pk2(S1[8 * s + 4], S1[8 * s + 5]); bq.w = pk2(S1[8 * s + 6], S1[8 * s + 7]);
                pf[0][s] = __builtin_bit_cast(bf16x8, a); pf[1][s] = __builtin_bit_cast(bf16x8, bq); }
#pragma unroll
            for (int dt = 0; dt < 4; ++dt)
#pragma unroll
                for (int kt = 0; kt < 2; ++kt)
#pragma unroll
                    for (int s = 0; s < 2; ++s) { const LP vp = Vc + (32 * dt + r) * 144 + (32 * kt + 16 * s + 4 * h) * 2;
                        const u32x2 lo = *(const PG8_LAS u32x2*)vp, hi = *(const PG8_LAS u32x2*)(vp + 16);
                        u32x4 vv; vv.x = lo.x; vv.y = lo.y; vv.z = hi.x; vv.w = hi.y;
                        O[dt] = MFMA32(__builtin_bit_cast(bf16x8, vv), pf[kt][s], O[dt]); }
            }
            if (c + 1 < nch) {
                const LP Kn = Kl + ((c + 1) & 1) * ATT_BUF, Vn = Vl + ((c + 1) & 1) * ATT_BUF;
#pragma unroll
                for (int i = 0; i < 2; ++i) { const int p = tid + 512 * i; *(PG8_LAS u32x4*)(Kn + (p >> 4) * 272 + (p & 15) * 16) = pre[i]; *(PG8_LAS u32x4*)(Vn + (p >> 3) * 144 + (p & 7) * 16) = pre[2 + i]; }
            }
            __syncthreads();
        }
#undef ATT_LOAD
        const float inv = 1.0f / lsum;
        bf16_t* op = MIX + (size_t)myrow * D + hq * 128 + 4 * h;
#pragma unroll
        for (int dt = 0; dt < 4; ++dt)
#pragma unroll
            for (int g = 0; g < 4; ++g) { u32x2 wv; wv.x = pk2(O[dt][4 * g] * inv, O[dt][4 * g + 1] * inv); wv.y = pk2(O[dt][4 * g + 2] * inv, O[dt][4 * g + 3] * inv);
                *(u32x2*)(op + 32 * dt + 8 * g) = wv; }
    }
}
DI void fixup_phase(CP P, int l) {
    unsigned char* ws = P->ws; const float* hb = (const float*)(ws + WS_HB); bf16_t* act = (bf16_t*)(ws + WS_ACT);
    const float* cw = P->in[I_CONVW] + (size_t)l * 3 * NUP; const float* cb = P->in[I_CONVB] + (size_t)l * NUP;
    const int nbd = l == 0 ? 128 : 120, total = nbd * (DFF / 4);
    for (int i = bid_l() * NTHR + tid_l(); i < total; i += gridDim.x * NTHR) {
        const int bd = i / (DFF / 4), ch = (i % (DFF / 4)) * 4;
        int blkB; if (bd < 120) { const int b = bd / 15, k = bd % 15 + 1; blkB = b * 16 + k; } else { blkB = 128 + 2 * (bd - 120) + 1; }
        const int blkA = blkB - 1, pn = ch >> 7, cl = ch & 127, ig = pn * 256 + cl, iv = ig + 128;
        const float* A2 = hb + ((size_t)blkA * 4 + 2) * NUP; const float* A3 = A2 + NUP; const float* B0 = hb + ((size_t)blkB * 4) * NUP; const float* B1 = B0 + NUP;
        const f32x4 gm2 = *(const f32x4*)(A2 + ig), gm1 = *(const f32x4*)(A3 + ig), g0 = *(const f32x4*)(B0 + ig), g1 = *(const f32x4*)(B1 + ig);
        const f32x4 vm2 = *(const f32x4*)(A2 + iv), vm1 = *(const f32x4*)(A3 + iv), v0 = *(const f32x4*)(B0 + iv), v1 = *(const f32x4*)(B1 + iv);
        const f32x4 w0g = *(const f32x4*)(cw + ch), w1g = *(const f32x4*)(cw + NUP + ch), w2g = *(const f32x4*)(cw + 2 * NUP + ch), bg = *(const f32x4*)(cb + ch);
        const f32x4 w0v = *(const f32x4*)(cw + DFF + ch), w1v = *(const f32x4*)(cw + NUP + DFF + ch), w2v = *(const f32x4*)(cw + 2 * NUP + DFF + ch), bv = *(const f32x4*)(cb + DFF + ch);
        const f32x4 cgA = bg + w0g * gm2 + w1g * gm1 + w2g * g0, cvA = bv + w0v * vm2 + w1v * vm1 + w2v * v0;
        const f32x4 cgB = bg + w0g * gm1 + w1g * g0 + w2g * g1, cvB = bv + w0v * vm1 + w1v * v0 + w2v * v1;
        f32x4 oA, oB;
#pragma unroll
        for (int e = 0; e < 4; ++e) { oA[e] = silu_f(cgA[e]) * cvA[e]; oB[e] = silu_f(cgB[e]) * cvB[e]; }
        u32x2 wa, wb; wa.x = pk2(oA[0], oA[1]); wa.y = pk2(oA[2], oA[3]); wb.x = pk2(oB[0], oB[1]); wb.y = pk2(oB[2], oB[3]);
        const size_t rowB = (size_t)blkB * 128;
        *(u32x2*)(act + (rowB - 1) * DFF + ch) = wa; *(u32x2*)(act + rowB * DFF + ch) = wb;
    }
}
#ifndef GEMM_ALIGN
#define GEMM_ALIGN true
#endif
#ifndef GEMM_SP2
#define GEMM_SP2 true
#endif
#define GEMM_CALL(EpiT, g, S, E) pg8::gemm_phase<EpiT, pg8::StaticOrder, GEMM_ALIGN, GEMM_SP2>(lds, g, S, E)
DI void gemm_in_phase(CP P, int l, LP lds, bool subset = false) {
    unsigned char* ws = P->ws; const bf16_t* H = (const bf16_t*)(ws + WS_H); const bf16_t* W = (const bf16_t*)(ws + WS_WIN + l * SZ_WIN); bf16_t* Pb = (bf16_t*)(ws + WS_P);
    { pg8::Gemm g; EpiP E; E.O = Pb; E.ldc = INW; g.A = H; g.Bt = W; g.M = l == 0 ? MT : NLAT; g.N = INW; g.K = D; E.row_off = 0; E.col_off = 0; E.gelu_from_pn = 8; E.ssq = (float*)(ws + WS_SSQ);
      pg8::StaticOrder S; S.init(g.M, g.N, gridDim.x, bid_l()); S.nkt = g.K / 64;
      if (subset) { const int b_ = bid_l(); if ((b_ >> 3) & 1) { S.init(g.M, g.N, 128, 0); S.nwg = 0; } else S.init(g.M, g.N, 128, (b_ >> 4) * 8 + (b_ & 7)); S.nkt = g.K / 64; }
      GEMM_CALL(EpiP, g, S, E); }
    if (l == 1) {
        pg8::Gemm g; g.A = H + (size_t)NLAT * D; g.Bt = W + (size_t)1024 * D; g.M = NCTX; g.N = 512; g.K = D;
        EpiKVPart E; E.kvp = (float*)(ws + WS_KVP);
        pg8::StaticOrder S; S.init(g.M, g.N, gridDim.x, bid_l()); S.nkt = g.K / 64; S.split = 1;
        GEMM_CALL(EpiKVPart, g, S, E);
        filler_phase(P, 3, lds);
    }
}
DI void gemm_res_phase(CP P, int l, int which, LP lds) {
    unsigned char* ws = P->ws; float* X = (float*)(ws + WS_X);
    pg8::Gemm g; g.M = l == 0 ? MT : NLAT; g.N = D;
    if (which == 0) { g.A = (const bf16_t*)(ws + WS_MIX); g.Bt = (const bf16_t*)(ws + WS_WOUT + l * SZ_WOUT); g.K = D; }
    else { g.A = (const bf16_t*)(ws + WS_ACT); g.Bt = (const bf16_t*)(ws + WS_WDN + l * SZ_WDN); g.K = DFF; }
    EpiRes E; E.out = X; E.gate = (const float*)(ws + WS_MOD) + ((size_t)l * 9 * 6 + (which ? 5 : 2)) * D;
    if (l == 0 && which == 0) { E.base_lat = P->in[I_X]; E.base_ctx = P->in[I_CTX]; } else { E.base_lat = X; E.base_ctx = X + (size_t)NLAT * D; }
    pg8::StaticOrder S; S.init(g.M, g.N, gridDim.x, bid_l()); S.nkt = g.K / 64; S.split = (gridDim.x == 256 && l == 0) ? 1 : 0;
    E.xpart = (float*)(ws + WS_XP);
    GEMM_CALL(EpiRes, g, S, E);
}
DI void gemm_up_phase(CP P, int l, LP lds) {
    unsigned char* ws = P->ws;
    pg8::Gemm g; g.A = (const bf16_t*)(ws + WS_H); g.Bt = (const bf16_t*)(ws + WS_WUP + l * SZ_WUP); g.M = l == 0 ? MT : NLAT; g.N = NUP; g.K = D;
    EpiConvGlu E; E.act = (bf16_t*)(ws + WS_ACT); E.hb = (float*)(ws + WS_HB); E.cw = P->in[I_CONVW] + (size_t)l * 3 * NUP; E.cb = P->in[I_CONVB] + (size_t)l * NUP;
    pg8::StaticOrder S; S.init(g.M, g.N, gridDim.x, bid_l()); S.nkt = g.K / 64;
    GEMM_CALL(EpiConvGlu, g, S, E);
}
__global__ void __launch_bounds__(NTHR, 2) fwd_kernel(Params Parg) {
    extern __shared__ __attribute__((aligned(16))) unsigned char lds_raw[];
    const LP lds = (LP)lds_raw;
    cg::grid_group grid = cg::this_grid();
    const int lo = Parg.ph_lo, hi = Parg.ph_hi; int ph = 0;
    if (lo < 0) grid.sync();
    volatile PG8_LAS unsigned* xst = (volatile PG8_LAS unsigned*)(lds + 131072);
    if (threadIdx.x < 4) xst[threadIdx.x] = 0u;
    __syncthreads();
    XcdBarrier xbar = xcd_barrier_post((unsigned*)(Parg.ws + WS_BAR), xst);
#ifndef REP_MASK
#define REP_MASK 0u
#endif
#ifndef EXTRA_SYNCS
#define EXTRA_SYNCS 0
#endif
#ifndef PH_MASK
#define PH_MASK 0xffffffffu
#endif
#define PHASE(id, body) do { if (ph >= lo && ph < hi) { if ((PH_MASK >> (id)) & 1u) { auto kp_ = __builtin_amdgcn_kernarg_segment_ptr(); asm volatile("" : "+s"(kp_)); const CP P = (CP)kp_; body; if ((REP_MASK >> (id)) & 1u) { xcd_barrier(xbar); body; } } if (ph + 1 < hi) xcd_barrier(xbar); for (int xs_ = 0; xs_ < EXTRA_SYNCS; ++xs_) xcd_barrier(xbar); } ++ph; } while (0)
    PHASE(0, prep_phase(P, lds));
#pragma nounroll
    for (int l = 0; l < 2; ++l) {
        const int M = l == 0 ? MT : NLAT;
        PHASE(1, norm_mod_phase(P, l, 0, MT, lds));
        do { if (ph >= lo && ph < hi) { { auto kp_ = __builtin_amdgcn_kernarg_segment_ptr(); asm volatile("" : "+s"(kp_)); const CP P = (CP)kp_; gemm_in_phase(P, l, lds); if (l == 0) filler_phase(P, 0, lds); }
#ifdef SUBSET_PROBE
            xcd_barrier(xbar); { auto kp_ = __builtin_amdgcn_kernarg_segment_ptr(); asm volatile("" : "+s"(kp_)); const CP P = (CP)kp_; gemm_in_phase(P, l, lds, true); }
#endif
            if (ph + 1 < hi) xcd_barrier(xbar); } ++ph; } while (0);
        PHASE(3, { if ((PH_MASK >> 11) & 1u) qk_phase(P, l); for (int rp_ = 0; rp_ <= (int)((REP_MASK >> 12) & 1u); ++rp_) vt_phase(P, l, lds); for (int rp_ = 0; rp_ <= (int)((REP_MASK >> 13) & 1u); ++rp_) pool_phase(P, l, lds); for (int rp_ = 0; rp_ <= (int)((REP_MASK >> 14) & 1u); ++rp_) sgu_phase(P, l, lds); });
        PHASE(4, { attn_phase(P, l, lds); if (l == 0) filler_phase(P, 2, lds); });
        PHASE(5, { gemm_res_phase(P, l, 0, lds); });
        PHASE(6, norm_mod_phase(P, l, 1, M, lds));
        PHASE(7, { gemm_up_phase(P, l, lds); if (l == 0) filler_phase(P, 1, lds); });
        PHASE(8, fixup_phase(P, l));
        PHASE(9, { gemm_res_phase(P, l, 1, lds); });
    }
    PHASE(10, final_norm_phase(P));
#undef PHASE
}
constexpr int N_PHASES = 20;

extern "C" void kernel_launch(void* const* d_in, const int* in_sizes, int n_in, void* d_out, int out_size, void* d_ws, size_t ws_size, hipStream_t stream) {
    static int grid = 0;
    if (grid == 0) {
        if (n_in != N_IN || ws_size < WS_END) { fprintf(stderr, "kernel_launch: need %d inputs and >= %zu bytes of workspace; got %d, %zu\n", (int)N_IN, (size_t)WS_END, n_in, ws_size); grid = -1; return; }
        int dev = 0, cus = 0, per_cu = 0;
        if (hipGetDevice(&dev) != hipSuccess || hipDeviceGetAttribute(&cus, hipDeviceAttributeMultiprocessorCount, dev) != hipSuccess) { fprintf(stderr, "kernel_launch: device query failed\n"); grid = -1; return; }
        if (hipFuncSetAttribute((const void*)fwd_kernel, hipFuncAttributeMaxDynamicSharedMemorySize, LDS_BYTES) != hipSuccess) { fprintf(stderr, "kernel_launch: hipFuncSetAttribute failed\n"); grid = -1; return; }
        if (hipOccupancyMaxActiveBlocksPerMultiprocessor(&per_cu, (const void*)fwd_kernel, NTHR, LDS_BYTES) != hipSuccess || per_cu < 1) { fprintf(stderr, "kernel_launch: occupancy query says %d blocks/CU\n", per_cu); (void)hipGetLastError(); }
        grid = cus;
    }
    if (grid < 0) return;
    if (hipMemsetAsync((unsigned char*)d_ws + WS_BAR, 0, 16384, stream) != hipSuccess) { fprintf(stderr, "kernel_launch: memset of the barrier words failed\n"); return; }
    Params p{};
    for (int i = 0; i < N_IN; ++i) p.in[i] = (const float*)d_in[i];
    p.out = (float*)d_out; p.ws = (unsigned char*)d_ws; p.ph_lo = 0; p.ph_hi = N_PHASES;
    void* args[] = {&p};
    const hipError_t e = hipLaunchCooperativeKernel((const void*)fwd_kernel, dim3(grid), dim3(NTHR), args, LDS_BYTES, stream);
    if (e != hipSuccess) fprintf(stderr, "kernel_launch: cooperative launch failed: %s (grid %d)\n", hipGetErrorString(e), grid);
}
```

```cpp
#define REP_MASK 0u
#define EXTRA_SYNCS 0
#include <hip/hip_runtime.h>
#include <hip/hip_cooperative_groups.h>
#include <cstdio>
#include <cstdint>
namespace cg = cooperative_groups;
namespace pg8 {
#define PG8_LAS __attribute__((address_space(3)))
typedef unsigned short bf16_t;
typedef short bf16x8 __attribute__((ext_vector_type(8)));
typedef float f32x4 __attribute__((ext_vector_type(4)));
typedef unsigned u32x4 __attribute__((ext_vector_type(4)));
constexpr int BM = 256, BK = 64, HALF = 128, HTB = HALF * BK * 2  , STAGE_BYTES = 8 * HTB, NXCD = 8, WGM = 4;

__host__ __device__ __forceinline__ int lds_byte(int r, int c) { const int st = (r >> 4) * 2 + (c >> 5), rr = r & 15, cc = c & 31, ob = rr * 64 + cc * 2; return st * 1024 + (ob ^ (((ob >> 9) & 1) << 5)); }
__host__ __device__ __forceinline__ void stage_rc(int b, int& R, int& C) { const int st = b / 1024, sb = b % 1024, swz = sb ^ (((sb >> 9) & 1) << 5); R = (st >> 1) * 16 + swz / 64; C = (st & 1) * 32 + (swz % 64) / 2; }
__host__ __device__ __forceinline__ int perm32(int rho) { const int n = rho >> 4, i = rho & 15; return 8 * (i >> 2) + 4 * n + (i & 3); }

struct Unit { int pm, pn, kt0, nkt, part, tidx; };
struct Gemm { const bf16_t* A; const bf16_t* Bt; int M, N, K; };

struct StaticOrder {
    int nM, nN, nwg, G, c;
    __host__ __device__ void init(int M, int N, int G_, int c_) { nM = M / BM; nN = N / BM; nwg = nM * nN; G = G_; c = c_; }
    __host__ __device__ bool next(int i, Unit& u) const {
        const long L = (long)i * G + c; if (L >= nwg) return false;
        int wgid = (int)L; { const int q = nwg / NXCD, r = nwg % NXCD, xcd = wgid % NXCD, off = wgid / NXCD; wgid = (xcd < r ? xcd * (q + 1) : r * (q + 1) + (xcd - r) * q) + off; }
        const int nig = WGM * nN, gid = wgid / nig, fm = gid * WGM, gsz = (nM - fm) < WGM ? (nM - fm) : WGM;
        u.pm = fm + ((wgid % nig) % gsz); u.pn = (wgid % nig) / gsz; u.kt0 = 0; u.nkt = nkt; u.part = 0; u.tidx = 0; return true;
    }
    int nkt = 0;
    int split = 0;
    __host__ __device__ bool next_split(int i, Unit& u) const {
        const int full = nwg / G;
        if (!split || i < full) return next(i, u);
        if (i > full) return false;
        const int x = c & 7, j = c >> 3, cp = (j >> 2) * 8 + x, quarter = j & 3;
        StaticOrder t = *this; t.c = cp;
        if (!t.next(full, u)) return false;
        u.nkt = nkt >> 2; u.kt0 = quarter * u.nkt; u.part = quarter; u.tidx = cp; return true;
    }
    __device__ __forceinline__ void a_ready(const Unit&) const {}
    __device__ __forceinline__ void done(const Unit&) const {}
};
typedef float f32x2 __attribute__((ext_vector_type(2)));
__device__ __forceinline__ f32x2 gelu_pk(f32x2 v) {
    const f32x2 av = __builtin_elementwise_abs(v), d = av * 0.2316418882f + 1.0f;
    f32x2 t; t.x = __builtin_amdgcn_rcpf(d.x); t.y = __builtin_amdgcn_rcpf(d.y);
    f32x2 q = t * 0.5307027145f + (-0.7265760135f); q = q * t + 0.7107068705f; q = q * t + (-0.142248368f); q = q * t + 0.127414796f; q = q * t;
    const f32x2 s = (v * v) * (-0.72134752044f);
    f32x2 e; e.x = __builtin_amdgcn_exp2f(s.x); e.y = __builtin_amdgcn_exp2f(s.y);
    const f32x2 m = v * (q * e), r = v - m;
    f32x2 o; o.x = v.x < 0.f ? m.x : r.x; o.y = v.y < 0.f ? m.y : r.y; return o;
}

template <class Epi, class Sched, bool ALIGN_EPI = false, bool SP2 = false>
__device__ __forceinline__ void gemm_phase(PG8_LAS unsigned char* lds, const Gemm g, const Sched& S, const Epi& E) {
    int tid = threadIdx.x; asm volatile("" : "+v"(tid)); const int wid = __builtin_amdgcn_readfirstlane(tid >> 6), lane = tid & 63, wr = wid >> 2, wc = wid & 3, fr = lane & 15, fq = lane >> 4;
    const int K = g.K;
    unsigned voffA[2], voffB[2];
#pragma unroll
    for (int i = 0; i < 2; ++i) { int R, C; stage_rc(tid * 16 + i * 8192, R, C); const int Rb = Epi::PERM ? ((R & ~31) + perm32(R & 31)) : R;
        const int Ra = Epi::ROWPERM ? (128 * ((R >> 6) & 1) + 8 * (R & 15) + ((R >> 4) & 3)) : R; voffA[i] = (unsigned)(Ra * K + C) * 2u; voffB[i] = (unsigned)(Rb * K + C) * 2u; }
    const size_t kstep = (size_t)(BK * 2);
    const size_t hstep = (size_t)HALF * K * 2;
    const size_t tstep = 2 * hstep; const size_t hstepA = Epi::ROWPERM ? (size_t)4 * K * 2 : hstep;
    const unsigned ldsw = (unsigned)wid * 1024u;
    const int aoff = lds_byte(wr * 64 + fr, fq * 8), boff = lds_byte(wc * 32 + fr, fq * 8);
#define PG8_SA(b, h) (((b) * 2 + (h)) * HTB)
#define PG8_SB(b, h) ((4 + (b) * 2 + (h)) * HTB)
#define PG8_STAGE(bufoff, gbase, voff) do { _Pragma("unroll") for (int _i = 0; _i < 2; ++_i) \
        __builtin_amdgcn_global_load_lds((const unsigned*)((const char*)(gbase) + (voff)[_i]), (PG8_LAS unsigned*)(lds + (bufoff) + ldsw + _i * 8192), 16, 0, 0); } while (0)
#define PG8_LDA(dst, b, h) do { _Pragma("unroll") for (int m = 0; m < 4; ++m) _Pragma("unroll") for (int k = 0; k < 2; ++k) dst[m][k] = *(const PG8_LAS bf16x8*)(lds + PG8_SA(b, h) + aoff + m * 2048 + k * 1024); } while (0)
#define PG8_LDB(dst, b, h) do { _Pragma("unroll") for (int n = 0; n < 2; ++n) _Pragma("unroll") for (int k = 0; k < 2; ++k) dst[n][k] = *(const PG8_LAS bf16x8*)(lds + PG8_SB(b, h) + boff + n * 2048 + k * 1024); } while (0)
#define PG8_MMA(ai, bj, At, Bt) do { __builtin_amdgcn_s_setprio(1); _Pragma("unroll") for (int m = 0; m < 4; ++m) _Pragma("unroll") for (int n = 0; n < 2; ++n) _Pragma("unroll") for (int k = 0; k < 2; ++k) \
        acc[ai][bj][m][n] = __builtin_amdgcn_mfma_f32_16x16x32_bf16(Bt[n][k], At[m][k], acc[ai][bj][m][n], 0, 0, 0); __builtin_amdgcn_s_setprio(0); } while (0)
#define PG8_WAIT_V(n) asm volatile("s_waitcnt vmcnt(" #n ")" ::: "memory")
#define PG8_WAIT_L(n) asm volatile("s_waitcnt lgkmcnt(" #n ")" ::: "memory")
#define PG8_BAR __builtin_amdgcn_s_barrier()
#define PG8_SCHED __builtin_amdgcn_sched_barrier(0)
    Unit cur, nxt; int ui = 0;
    if (!S.next_split(0, cur)) return;
    f32x4 acc[2][2][4][2];
#pragma unroll
    for (int a = 0; a < 2; ++a)
#pragma unroll
        for (int b = 0; b < 2; ++b)
#pragma unroll
            for (int m = 0; m < 4; ++m)
#pragma unroll
                for (int n = 0; n < 2; ++n) acc[a][b][m][n] = (f32x4){0.f, 0.f, 0.f, 0.f};
    bf16x8 At[4][2], B0[2][2], B1[2][2];
    const char* cA = (const char*)g.A + (size_t)cur.pm * tstep + (size_t)cur.kt0 * kstep; const char* cB = (const char*)g.Bt + (size_t)cur.pn * tstep + (size_t)cur.kt0 * kstep;
    S.a_ready(cur);
    if constexpr (SP2) {
        PG8_STAGE(PG8_SB(0, 0), cB, voffB); PG8_STAGE(PG8_SB(0, 1), cB + hstep, voffB); PG8_STAGE(PG8_SA(0, 0), cA, voffA); PG8_STAGE(PG8_SA(0, 1), cA + hstepA, voffA);
        if (wr == 1) PG8_BAR;
        PG8_WAIT_V(2); PG8_BAR;
        PG8_STAGE(PG8_SB(1, 0), cB + kstep, voffB); PG8_STAGE(PG8_SA(1, 0), cA + kstep, voffA); PG8_STAGE(PG8_SB(1, 1), cB + hstep + kstep, voffB);
        PG8_WAIT_V(6); PG8_BAR;
    } else {
        PG8_STAGE(PG8_SB(0, 0), cB, voffB); PG8_STAGE(PG8_SA(0, 0), cA, voffA); PG8_STAGE(PG8_SB(0, 1), cB + hstep, voffB); PG8_STAGE(PG8_SA(0, 1), cA + hstepA, voffA);
        if (wr == 1) PG8_BAR;
        PG8_WAIT_V(4); PG8_BAR;
        PG8_STAGE(PG8_SB(1, 0), cB + kstep, voffB); PG8_STAGE(PG8_SA(1, 0), cA + kstep, voffA); PG8_STAGE(PG8_SB(1, 1), cB + hstep + kstep, voffB);
        PG8_WAIT_V(6); PG8_BAR;
    }
    for (;;) {
        const bool has_next = S.next_split(ui + 1, nxt); const int nt = cur.nkt;
        const char* nA = has_next ? (const char*)g.A + (size_t)nxt.pm * tstep + (size_t)nxt.kt0 * kstep : cA; const char* nB = has_next ? (const char*)g.Bt + (size_t)nxt.pn * tstep + (size_t)nxt.kt0 * kstep : cB;
        for (int t = 0; t < nt; t += 2) {
            const bool last = (t == nt - 2);
            const char* a1 = cA + (size_t)(t + 1) * kstep;
            const char* a2 = last ? nA : cA + (size_t)(t + 2) * kstep; const char* b2 = last ? nB : cB + (size_t)(t + 2) * kstep;
            const char* a3 = a2 + kstep; const char* b3 = b2 + kstep;
            if (last && has_next) S.a_ready(nxt);
            if constexpr (SP2) {
            PG8_LDB(B0, 0, 0); PG8_LDB(B1, 0, 1); PG8_SCHED; PG8_LDA(At, 0, 0); PG8_STAGE(PG8_SA(1, 1), a1 + hstepA, voffA);
            PG8_WAIT_V(8); PG8_WAIT_L(0); PG8_BAR; PG8_MMA(0, 0, At, B0); PG8_MMA(0, 1, At, B1); PG8_BAR; PG8_SCHED;
            PG8_LDA(At, 0, 1); PG8_STAGE(PG8_SB(0, 0), b2, voffB); PG8_STAGE(PG8_SB(0, 1), b2 + hstep, voffB); PG8_STAGE(PG8_SA(0, 0), a2, voffA);
            PG8_WAIT_V(8); PG8_WAIT_L(0); PG8_BAR; PG8_MMA(1, 0, At, B0); PG8_MMA(1, 1, At, B1); PG8_BAR; PG8_SCHED;
            PG8_LDB(B0, 1, 0); PG8_LDB(B1, 1, 1); PG8_SCHED; PG8_LDA(At, 1, 0); PG8_STAGE(PG8_SA(0, 1), a2 + hstepA, voffA);
            PG8_WAIT_V(8); PG8_WAIT_L(0); PG8_BAR; PG8_MMA(0, 0, At, B0); PG8_MMA(0, 1, At, B1); PG8_BAR; PG8_SCHED;
            PG8_LDA(At, 1, 1); PG8_STAGE(PG8_SB(1, 0), b3, voffB); PG8_STAGE(PG8_SB(1, 1), b3 + hstep, voffB); PG8_STAGE(PG8_SA(1, 0), a3, voffA);
            PG8_WAIT_V(8); PG8_WAIT_L(0); PG8_BAR; PG8_MMA(1, 0, At, B0); PG8_MMA(1, 1, At, B1); PG8_BAR; PG8_SCHED;
            } else {
            PG8_LDB(B0, 0, 0); PG8_SCHED; PG8_LDA(At, 0, 0); PG8_STAGE(PG8_SA(1, 1), a1 + hstepA, voffA);
            PG8_WAIT_L(8); PG8_BAR; PG8_WAIT_L(0); PG8_MMA(0, 0, At, B0); PG8_BAR; PG8_SCHED;
            PG8_LDB(B1, 0, 1); PG8_STAGE(PG8_SB(0, 0), b2, voffB);
            PG8_BAR; PG8_WAIT_L(0); PG8_MMA(0, 1, At, B1); PG8_BAR;
            PG8_LDA(At, 0, 1); PG8_STAGE(PG8_SA(0, 0), a2, voffA);
            PG8_BAR; PG8_WAIT_L(0); PG8_MMA(1, 0, At, B0); PG8_BAR; PG8_SCHED;
            PG8_STAGE(PG8_SB(0, 1), b2 + hstep, voffB);
            PG8_WAIT_V(6); PG8_BAR; PG8_MMA(1, 1, At, B1); PG8_BAR;
            PG8_LDB(B0, 1, 0); PG8_SCHED; PG8_LDA(At, 1, 0); PG8_STAGE(PG8_SA(0, 1), a2 + hstepA, voffA);
            PG8_WAIT_L(8); PG8_BAR; PG8_WAIT_L(0); PG8_MMA(0, 0, At, B0); PG8_BAR; PG8_SCHED;
            PG8_LDB(B1, 1, 1); PG8_STAGE(PG8_SB(1, 0), b3, voffB);
            PG8_BAR; PG8_WAIT_L(0); PG8_MMA(0, 1, At, B1); PG8_BAR;
            PG8_LDA(At, 1, 1); PG8_STAGE(PG8_SA(1, 0), a3, voffA);
            PG8_BAR; PG8_WAIT_L(0); PG8_MMA(1, 0, At, B0); PG8_BAR; PG8_SCHED;
            PG8_STAGE(PG8_SB(1, 1), b3 + hstep, voffB);
            PG8_WAIT_V(6); PG8_BAR; PG8_MMA(1, 1, At, B1); PG8_BAR;
            }
        }
        if constexpr (ALIGN_EPI) { if (wr == 0) PG8_BAR; }
        if constexpr (!Epi::AFTER_DRAIN) { E(acc, cur, wr, wc, fr, fq); S.done(cur); }
        if (!has_next) break;
#pragma unroll
        for (int a = 0; a < 2; ++a)
#pragma unroll
            for (int b = 0; b < 2; ++b)
#pragma unroll
                for (int m = 0; m < 4; ++m)
#pragma unroll
                    for (int n = 0; n < 2; ++n) acc[a][b][m][n] = (f32x4){0.f, 0.f, 0.f, 0.f};
        cur = nxt; cA = nA; cB = nB; ++ui;
        if constexpr (ALIGN_EPI) { if (wr == 1) PG8_BAR; }
    }
    PG8_WAIT_V(0);
    if constexpr (!ALIGN_EPI) { if (wr == 0) PG8_BAR; }
    PG8_BAR;
    if constexpr (Epi::AFTER_DRAIN) { E.fused(acc, cur, wr, wc, fr, fq, lds, wid, lane); S.done(cur); }
#undef PG8_SA
#undef PG8_SB
#undef PG8_STAGE
#undef PG8_LDA
#undef PG8_LDB
#undef PG8_MMA
#undef PG8_WAIT_V
#undef PG8_WAIT_L
#undef PG8_BAR
#undef PG8_SCHED
}
}
using pg8::bf16_t; using pg8::bf16x8; using pg8::f32x4; using pg8::u32x4; using pg8::Unit;
typedef PG8_LAS unsigned char* LP;
typedef unsigned u32x2 __attribute__((ext_vector_type(2)));
typedef float f32x2 __attribute__((ext_vector_type(2)));
typedef float f32x16 __attribute__((ext_vector_type(16)));
typedef __bf16 bf16x2_t __attribute__((ext_vector_type(2)));
#define DI __device__ __forceinline__

constexpr int D = 2048, NB = 8, SEQ = 2048, CTXL = 256, NLAT = NB * SEQ, NCTX = NB * CTXL, MT = NLAT + NCTX;
constexpr int INW = 3072, DFF = 5632, NUP = 2 * DFF;
constexpr int NTHR = 512;
constexpr float EPS = 1e-6f;
constexpr float LOG2E = 1.4426950408889634f;
constexpr float QSCALE = 0.08838834764831845f * 1.4426950408889634f;
constexpr int LDS_BYTES = 131072 + 16;
enum { I_X = 0, I_C, I_CTX, I_CCTX, I_N1G, I_N2G, I_WADA, I_BADA, I_WIN, I_QNG, I_KNG, I_SINK, I_POOLW, I_POOLS, I_SGUNG, I_SGUW, I_SGUB, I_WOUT, I_WUP, I_CONVW, I_CONVB, I_WDOWN, I_FNG, N_IN };
constexpr size_t SZ_WIN = (size_t)INW * D * 2, SZ_WOUT = (size_t)D * D * 2, SZ_WUP = (size_t)NUP * D * 2, SZ_WDN = (size_t)D * DFF * 2;
constexpr size_t WS_WIN = 0, WS_WOUT = WS_WIN + 2 * SZ_WIN, WS_WUP = WS_WOUT + 2 * SZ_WOUT, WS_WDN = WS_WUP + 2 * SZ_WUP;
constexpr size_t WS_BAR = WS_WDN + 2 * SZ_WDN;
constexpr size_t WS_MOD = WS_BAR + 16384;
constexpr size_t WS_ROPE = WS_MOD + (size_t)2 * 9 * 6 * D * 4;
constexpr size_t WS_H = WS_ROPE + 64 * 32 * 2 * 4;
constexpr size_t WS_X = WS_H + (size_t)MT * D * 2;
constexpr size_t WS_HB = WS_X + (size_t)MT * D * 4;
constexpr size_t WS_R1 = WS_HB + (size_t)144 * 4 * NUP * 4;
constexpr size_t WS_P = WS_R1;
constexpr size_t WS_MIX = WS_P + (size_t)MT * INW * 2;
constexpr size_t WS_VTL = WS_MIX + (size_t)MT * D * 2;
constexpr size_t WS_VTC = WS_VTL + (size_t)NB * 2 * 128 * SEQ * 2;
constexpr size_t WS_R1_END_A = WS_VTC + (size_t)NB * 2 * 128 * CTXL * 2;
constexpr size_t WS_ACT = WS_R1;
constexpr size_t WS_R1_END_B = WS_ACT + (size_t)MT * DFF * 2;
constexpr size_t WS_XP = WS_R1_END_A > WS_R1_END_B ? WS_R1_END_A : WS_R1_END_B;
constexpr size_t WS_KVP = WS_XP + (size_t)64 * 3 * 65536 * 4;
constexpr size_t WS_SSQ = WS_KVP + (size_t)4 * NCTX * 512 * 4;
constexpr size_t WS_END = WS_SSQ + (size_t)MT * 4;

struct Params { const float* in[N_IN]; float* out; unsigned char* ws; int ph_lo, ph_hi; };
typedef const __attribute__((address_space(4))) Params* CP;

DI int tid_l() { int t = threadIdx.x; asm volatile("" : "+v"(t)); return t; }
DI int bid_l() { int b = blockIdx.x; asm volatile("" : "+s"(b)); return b; }
DI unsigned pk2(float a, float b) { f32x2 v = {a, b}; bf16x2_t r = __builtin_convertvector(v, bf16x2_t); return __builtin_bit_cast(unsigned, r); }
DI float bf_lo(unsigned w) { return __uint_as_float(w << 16); }
DI float bf_hi(unsigned w) { return __uint_as_float(w & 0xffff0000u); }
DI float silu_f(float x) { return x * __builtin_amdgcn_rcpf(1.0f + __builtin_amdgcn_exp2f(-x * LOG2E)); }
DI float gelu_f(float x) { f32x2 v = {x, x}; return pg8::gelu_pk(v).x; }
DI f32x4 gelu4(f32x4 x) { f32x2 a = pg8::gelu_pk((f32x2){x[0], x[1]}), b = pg8::gelu_pk((f32x2){x[2], x[3]}); return (f32x4){a.x, a.y, b.x, b.y}; }

struct EpiP {
    static constexpr bool PERM = true, AFTER_DRAIN = false, ROWPERM = false;
    float* ssq;
    bf16_t* O; int ldc, row_off, col_off, gelu_from_pn;
    DI void operator()(const f32x4 (&acc)[2][2][4][2], const Unit& u, int wr, int wc, int fr, int fq) const {
        const int row0 = row_off + u.pm * 256 + wr * 64 + fr, col0 = col_off + u.pn * 256 + wc * 32 + 8 * fq;
        const bool gsq = (u.pn >= 10) && (gelu_from_pn < 12);
#pragma unroll
        for (int ai = 0; ai < 2; ++ai)
#pragma unroll
            for (int m = 0; m < 4; ++m) { bf16_t* rowp = O + (size_t)(row0 + ai * 128 + m * 16) * ldc + col0; float s = 0.f;
#pragma unroll
                for (int bj = 0; bj < 2; ++bj) { f32x4 v0 = acc[ai][bj][m][0], v1 = acc[ai][bj][m][1];
                    if (u.pn >= gelu_from_pn) { v0 = gelu4(v0); v1 = gelu4(v1); }
                    s += v0[0] * v0[0] + v0[1] * v0[1] + v0[2] * v0[2] + v0[3] * v0[3] + v1[0] * v1[0] + v1[1] * v1[1] + v1[2] * v1[2] + v1[3] * v1[3];
                    u32x4 w; w.x = pk2(v0[0], v0[1]); w.y = pk2(v0[2], v0[3]); w.z = pk2(v1[0], v1[1]); w.w = pk2(v1[2], v1[3]);
                    *(u32x4*)(rowp + bj * 128) = w; }
                if (gsq) { s += __shfl_xor(s, 16); s += __shfl_xor(s, 32); if (fq == 0) atomicAdd(ssq + row0 + ai * 128 + m * 16, s); } }
    }
};
struct EpiKVPart {
    static constexpr bool PERM = false, AFTER_DRAIN = false, ROWPERM = false;
    float* kvp;
    DI void operator()(const f32x4 (&acc)[2][2][4][2], const Unit& u, int wr, int wc, int fr, int fq) const {
        float* op = kvp + ((size_t)u.part * NCTX + u.pm * 256 + wr * 64 + fr) * 512 + u.pn * 256 + wc * 32 + 4 * fq;
#pragma unroll
        for (int ai = 0; ai < 2; ++ai)
#pragma unroll
            for (int m = 0; m < 4; ++m)
#pragma unroll
                for (int bj = 0; bj < 2; ++bj)
#pragma unroll
                    for (int n = 0; n < 2; ++n) *(f32x4*)(op + (size_t)(ai * 128 + m * 16) * 512 + bj * 128 + n * 16) = acc[ai][bj][m][n];
    }
};
struct EpiRes {
    static constexpr bool PERM = false, AFTER_DRAIN = false, ROWPERM = false;
    const float* base_lat; const float* base_ctx; float* out; float* xpart; const float* gate;
    DI void operator()(const f32x4 (&acc)[2][2][4][2], const Unit& u, int wr, int wc, int fr, int fq) const {
        const int row0 = u.pm * 256 + wr * 64 + fr, col0 = u.pn * 256 + wc * 32 + 4 * fq;
        const int b = u.pm < 64 ? (u.pm >> 3) : 8;
        const float* gp = gate + (size_t)b * 6 * D + col0;
        f32x4 gv[2][2];
#pragma unroll
        for (int bj = 0; bj < 2; ++bj)
#pragma unroll
            for (int n = 0; n < 2; ++n) gv[bj][n] = *(const f32x4*)(gp + bj * 128 + n * 16);
        if (u.part != 0) {
            float* xp = xpart + ((size_t)(u.tidx * 3 + u.part - 1) << 16) + (size_t)(wr * 64 + fr) * 256 + wc * 32 + 4 * fq;
#pragma unroll
            for (int ai = 0; ai < 2; ++ai)
#pragma unroll
                for (int m = 0; m < 4; ++m)
#pragma unroll
                    for (int bj = 0; bj < 2; ++bj)
#pragma unroll
                        for (int n = 0; n < 2; ++n) *(f32x4*)(xp + (size_t)(ai * 128 + m * 16) * 256 + bj * 128 + n * 16) = gv[bj][n] * acc[ai][bj][m][n];
            return;
        }
        const float* bp = (u.pm < 64 ? base_lat + (size_t)row0 * D : base_ctx + (size_t)(row0 - NLAT) * D) + col0;
        float* op = out + (size_t)row0 * D + col0;
        f32x4 bs[4], bn[4];
#pragma unroll
        for (int q = 0; q < 4; ++q) bs[q] = *(const f32x4*)(bp + (q >> 1) * 128 + (q & 1) * 16);
#pragma unroll
        for (int g = 0; g < 8; ++g) { const int ai = g >> 2, m = g & 3; const size_t off = (size_t)(ai * 128 + m * 16) * D;
            if (g < 7) { const size_t offn = (size_t)(((g + 1) >> 2) * 128 + ((g + 1) & 3) * 16) * D;
#pragma unroll
                for (int q = 0; q < 4; ++q) bn[q] = *(const f32x4*)(bp + offn + (q >> 1) * 128 + (q & 1) * 16); }
#pragma unroll
            for (int q = 0; q < 4; ++q) { const int bj = q >> 1, n = q & 1; *(f32x4*)(op + off + bj * 128 + n * 16) = bs[q] + gv[bj][n] * acc[ai][bj][m][n]; }
            asm volatile("" ::: "memory");
#pragma unroll
            for (int q = 0; q < 4; ++q) bs[q] = bn[q]; }
    }
};
struct EpiConvGlu {
    static constexpr bool PERM = true, AFTER_DRAIN = false, ROWPERM = true;
    bf16_t* act; float* hb; const float* cw; const float* cb;
    DI void operator()(const f32x4 (&acc)[2][2][4][2], const Unit& u, int wr, int wc, int fr, int fq) const {
        const int tok0 = u.pm * 256 + 128 * wr + 8 * fr, cl0 = wc * 32 + 8 * fq;
#pragma unroll
        for (int n = 0; n < 2; ++n) {
            const int cl = cl0 + 4 * n, chg = u.pn * 128 + cl, chv = DFF + chg;
            const f32x4 w0g = *(const f32x4*)(cw + chg), w1g = *(const f32x4*)(cw + NUP + chg), w2g = *(const f32x4*)(cw + 2 * NUP + chg), bg = *(const f32x4*)(cb + chg);
            const f32x4 w0v = *(const f32x4*)(cw + chv), w1v = *(const f32x4*)(cw + NUP + chv), w2v = *(const f32x4*)(cw + 2 * NUP + chv), bv = *(const f32x4*)(cb + chv);
            f32x4 gp, gn, vp, vn;
#pragma unroll
            for (int e = 0; e < 4; ++e) {
                gp[e] = __int_as_float(__builtin_amdgcn_update_dpp(0, __float_as_int(acc[1][0][3][n][e]), 0x111, 0xf, 0xf, true)); gn[e] = __int_as_float(__builtin_amdgcn_update_dpp(0, __float_as_int(acc[0][0][0][n][e]), 0x101, 0xf, 0xf, true));
                vp[e] = __int_as_float(__builtin_amdgcn_update_dpp(0, __float_as_int(acc[1][1][3][n][e]), 0x111, 0xf, 0xf, true)); vn[e] = __int_as_float(__builtin_amdgcn_update_dpp(0, __float_as_int(acc[0][1][0][n][e]), 0x101, 0xf, 0xf, true)); }
            if (fr == 0) { gp = (f32x4){0.f, 0.f, 0.f, 0.f}; vp = gp; }
            if (fr == 15) { gn = (f32x4){0.f, 0.f, 0.f, 0.f}; vn = gn; }
            if (fr == 0 || fr == 15) {
                float* hp = hb + ((size_t)(u.pm * 2 + wr) * 4 + (fr ? 2 : 0)) * NUP + u.pn * 256 + cl;
                const int j0 = fr ? 6 : 0;
                const f32x4 g0 = fr ? acc[1][0][2][n] : acc[0][0][0][n], g1 = fr ? acc[1][0][3][n] : acc[0][0][1][n];
                const f32x4 v0 = fr ? acc[1][1][2][n] : acc[0][1][0][n], v1 = fr ? acc[1][1][3][n] : acc[0][1][1][n];
                (void)j0;
                *(f32x4*)(hp) = g0; *(f32x4*)(hp + 128) = v0; *(f32x4*)(hp + NUP) = g1; *(f32x4*)(hp + NUP + 128) = v1;
            }
#pragma unroll
            for (int j = 0; j < 8; ++j) {
                const f32x4 gP = j ? acc[(j - 1) >> 2][0][(j - 1) & 3][n] : gp, gC = acc[j >> 2][0][j & 3][n], gN = j < 7 ? acc[(j + 1) >> 2][0][(j + 1) & 3][n] : gn;
                const f32x4 vP = j ? acc[(j - 1) >> 2][1][(j - 1) & 3][n] : vp, vC = acc[j >> 2][1][j & 3][n], vN = j < 7 ? acc[(j + 1) >> 2][1][(j + 1) & 3][n] : vn;
                const f32x4 cg_ = bg + w0g * gP + w1g * gC + w2g * gN, cv_ = bv + w0v * vP + w1v * vC + w2v * vN;
                f32x4 o;
#pragma unroll
                for (int e = 0; e < 4; ++e) o[e] = silu_f(cg_[e]) * cv_[e];
                u32x2 w; w.x = pk2(o[0], o[1]); w.y = pk2(o[2], o[3]);
                *(u32x2*)(act + (size_t)(tok0 + j) * DFF + u.pn * 128 + cl) = w;
            }
            asm volatile("" ::: "memory");
        }
    }
};
#include <cstdlib>
#include <vector>

#define XB_TMO      128
#define XB_XCNT(j)  (256  + 64 * (j))
#define XB_XSUB(j)  (1280 + 64 * (j))
#define XB_XGEN(j)  (2304 + 64 * (j))
#define XB_TOP      3328
#define XB_TOPGEN   3392
#define XCD_BAR_WORDS 3456
#define XB_SPIN_CAP (1u << 18)

__device__ __forceinline__ unsigned xb_ld(unsigned* p)              { return __hip_atomic_load(p, __ATOMIC_RELAXED, __HIP_MEMORY_SCOPE_AGENT); }
__device__ __forceinline__ unsigned xb_add(unsigned* p, unsigned v) { return __hip_atomic_fetch_add(p, v, __ATOMIC_RELAXED, __HIP_MEMORY_SCOPE_AGENT); }
__device__ __forceinline__ unsigned xb_xcc_id() { return (unsigned)__builtin_amdgcn_s_getreg((3 << 11) | 20) & 0xFu; }
#define XB_SPIN(cond, bar) do { unsigned _sp = 0; while (cond) { __builtin_amdgcn_s_sleep(1); \
    if ((++_sp & 255u) == 0u) { if (xb_ld(&(bar)[XB_TMO])) break; if (_sp > XB_SPIN_CAP) { atomicAdd(&(bar)[XB_TMO], 1u); break; } } } } while (0)

struct XcdBarrier {
    unsigned* bar; unsigned x;
    volatile PG8_LAS unsigned* st;
};

__device__ __forceinline__ XcdBarrier xcd_barrier_post(unsigned* bar, volatile PG8_LAS unsigned* st) {
    XcdBarrier b; b.bar = bar; b.x = xb_xcc_id(); b.st = st;
    if (threadIdx.x == 0) (void)xb_add(&bar[XB_XCNT(b.x)], 1u);
    return b;
}
__device__ __forceinline__ void xcd_barrier_complete(unsigned* bar, unsigned x, unsigned& nloc, unsigned& nx) {
    const unsigned G = gridDim.x * gridDim.y * gridDim.z;
    unsigned sum, cnt, mine, sp = 0u;
    for (;;) {
        sum = 0u; cnt = 0u; mine = 0u;
#pragma unroll
        for (unsigned j = 0; j < 16; ++j) { const unsigned c = xb_ld(&bar[XB_XCNT(j)]); sum += c; cnt += (c > 0u) ? 1u : 0u; mine = (j == x) ? c : mine; }
        if (sum == G) break;
        __builtin_amdgcn_s_sleep(1);
        if ((++sp & 255u) == 0u) { if (xb_ld(&bar[XB_TMO])) break; if (sp > XB_SPIN_CAP) { atomicAdd(&bar[XB_TMO], 1u); break; } }
    }
    nloc = mine > 0u ? mine : 1u; nx = cnt > 0u ? cnt : 1u;
}

__device__ __forceinline__ void xcd_barrier(const XcdBarrier& b) {
    asm volatile("s_waitcnt vmcnt(0)" ::: "memory");
    __syncthreads();
    if (threadIdx.x == 0) {
        unsigned* bar = b.bar;
        __builtin_amdgcn_s_waitcnt(0);
        unsigned nloc = b.st[0], nx = b.st[1];
        if (nloc == 0u) { xcd_barrier_complete(bar, b.x, nloc, nx); b.st[0] = nloc; b.st[1] = nx; }
        const unsigned old = xb_add(&bar[XB_XSUB(b.x)], 1u);
        const unsigned gen = old / nloc;
        if (old + 1u == (gen + 1u) * nloc) {
            __builtin_amdgcn_fence(__ATOMIC_RELEASE, "agent");
            asm volatile("s_waitcnt vmcnt(0)" ::: "memory");
            const unsigned og = xb_add(&bar[XB_TOP], 1u);
            const unsigned tg = og / nx;
            if (og + 1u == (tg + 1u) * nx) xb_add(&bar[XB_TOPGEN], 1u);
            else XB_SPIN(xb_ld(&bar[XB_TOPGEN]) == tg, bar);
            __builtin_amdgcn_fence(__ATOMIC_ACQUIRE, "agent");
            xb_add(&bar[XB_XGEN(b.x)], 1u);
            asm volatile("s_waitcnt vmcnt(0)" ::: "memory");
        } else {
            XB_SPIN(xb_ld(&bar[XB_XGEN(b.x)]) == gen, bar);
            __builtin_amdgcn_fence(__ATOMIC_ACQUIRE, "agent");
            asm volatile("s_waitcnt vmcnt(0)" ::: "memory");
        }
    }
    __syncthreads();
}
DI void conv_tile(const float* __restrict__ W, int N, int k0, int srcc0, bf16_t* __restrict__ Wt, int K, int dstn0, LP lds, int tid) {
    PG8_LAS float* tile = (PG8_LAS float*)lds;
#pragma unroll
    for (int i = 0; i < 4; ++i) { const int k = (tid >> 4) + 32 * i, n4 = (tid & 15) * 4;
        const f32x4 v = *(const f32x4*)(W + (size_t)(k0 + k) * N + srcc0 + n4);
        tile[k * 65 + n4 + 0] = v[0]; tile[k * 65 + n4 + 1] = v[1]; tile[k * 65 + n4 + 2] = v[2]; tile[k * 65 + n4 + 3] = v[3]; }
    __syncthreads();
    const int n = tid >> 3, ks = (tid & 7) * 16;
    u32x4 o0, o1;
    o0.x = pk2(tile[(ks + 0) * 65 + n], tile[(ks + 1) * 65 + n]); o0.y = pk2(tile[(ks + 2) * 65 + n], tile[(ks + 3) * 65 + n]);
    o0.z = pk2(tile[(ks + 4) * 65 + n], tile[(ks + 5) * 65 + n]); o0.w = pk2(tile[(ks + 6) * 65 + n], tile[(ks + 7) * 65 + n]);
    o1.x = pk2(tile[(ks + 8) * 65 + n], tile[(ks + 9) * 65 + n]); o1.y = pk2(tile[(ks + 10) * 65 + n], tile[(ks + 11) * 65 + n]);
    o1.z = pk2(tile[(ks + 12) * 65 + n], tile[(ks + 13) * 65 + n]); o1.w = pk2(tile[(ks + 14) * 65 + n], tile[(ks + 15) * 65 + n]);
    bf16_t* dp = Wt + (size_t)(dstn0 + n) * K + k0 + ks;
    *(u32x4*)dp = o0; *(u32x4*)(dp + 8) = o1;
    __syncthreads();
}
DI void adaln_item(CP P, int item, LP lds) {
    const int tid = tid_l(); unsigned char* ws = P->ws;
    const int l = item / 96, n0 = (item % 96) * 128;
    PG8_LAS float* s = (PG8_LAS float*)lds;
    { float cv_[36];
#pragma unroll
      for (int q = 0; q < 36; ++q) { const int i = tid + q * NTHR, b = i >> 11, k = i & 2047; cv_[q] = b < 8 ? P->in[I_C][b * D + k] : P->in[I_CCTX][k]; }
#pragma unroll
      for (int q = 0; q < 36; ++q) s[tid + q * NTHR] = silu_f(cv_[q]); }
    __syncthreads();
    const int kg = tid >> 5, cq = tid & 31;
    float acc[9][4];
#pragma unroll
    for (int b = 0; b < 9; ++b)
#pragma unroll
        for (int e = 0; e < 4; ++e) acc[b][e] = 0.f;
    const float* W = P->in[I_WADA] + (size_t)l * D * 6 * D + n0 + 4 * cq;
#pragma unroll 8
    for (int kk = 0; kk < 128; ++kk) { const int k = kg * 128 + kk; const f32x4 w = __builtin_nontemporal_load((const f32x4*)(W + (size_t)k * 6 * D));
#pragma unroll
        for (int b = 0; b < 9; ++b) { const float sv = s[b * D + k];
#pragma unroll
            for (int e = 0; e < 4; ++e) acc[b][e] += sv * w[e]; } }
    __syncthreads();
    PG8_LAS float* red = (PG8_LAS float*)lds;
#pragma unroll
    for (int b = 0; b < 9; ++b)
#pragma unroll
        for (int e = 0; e < 4; ++e) red[(kg * 9 + b) * 128 + 4 * cq + e] = acc[b][e];
    __syncthreads();
    float* mod = (float*)(ws + WS_MOD);
    for (int o = tid; o < 9 * 128; o += NTHR) { const int b = o >> 7, ci = o & 127; float sum = P->in[I_BADA][l * 6 * D + n0 + ci];
        for (int g = 0; g < 16; ++g) sum += red[(g * 9 + b) * 128 + ci];
        mod[((size_t)l * 9 + b) * 6 * D + n0 + ci] = sum; }
    __syncthreads();
}
struct TileDesc { const float* src; bf16_t* dst; int srcN, dstK; };
DI TileDesc tile_desc(CP P, int T) {
    unsigned char* ws = P->ws; TileDesc d;
    const int l = T / 5504; int t = T % 5504;
    if (t < 768) { const int kt = t / 48, nt = t % 48; d.srcN = INW; d.dstK = D; d.src = P->in[I_WIN] + (size_t)l * D * INW + (size_t)(kt * 128) * INW + nt * 64; d.dst = (bf16_t*)(ws + WS_WIN + l * SZ_WIN) + (size_t)(nt * 64) * D + kt * 128; return d; }
    t -= 768;
    if (t < 512) { const int kt = t / 32, nt = t % 32; d.srcN = D; d.dstK = D; d.src = P->in[I_WOUT] + (size_t)l * D * D + (size_t)(kt * 128) * D + nt * 64; d.dst = (bf16_t*)(ws + WS_WOUT + l * SZ_WOUT) + (size_t)(nt * 64) * D + kt * 128; return d; }
    t -= 512;
    if (t < 2816) { const int kt = t / 176, nt = t % 176; const int np = nt * 64, pn = np >> 8, rem = np & 255; const int srcc = rem < 128 ? 128 * pn + rem : DFF + 128 * pn + rem - 128;
        d.srcN = NUP; d.dstK = D; d.src = P->in[I_WUP] + (size_t)l * D * NUP + (size_t)(kt * 128) * NUP + srcc; d.dst = (bf16_t*)(ws + WS_WUP + l * SZ_WUP) + (size_t)np * D + kt * 128; return d; }
    t -= 2816;
    { const int kt = t / 32, nt = t % 32; d.srcN = D; d.dstK = DFF; d.src = P->in[I_WDOWN] + (size_t)l * DFF * D + (size_t)(kt * 128) * D + nt * 64; d.dst = (bf16_t*)(ws + WS_WDN + l * SZ_WDN) + (size_t)(nt * 64) * DFF + kt * 128; return d; }
}
constexpr int FILL_PER = 12, FILL_TILES = 2 * 160 * FILL_PER;
DI int prep_tile_index(int bid, int G, int k) {
    if (G != 256) { const int T = bid + G * k; return T < 11008 ? T : -1; }
    if (bid >= 192) { if (k < 10) return (bid - 192) + 64 * k; k -= 10; }
    const int T = 640 + bid + 256 * k; return T < 5248 ? T : -1;
}
DI void convert_tiles_lin(CP P, LP lds, int Tbase, int stride, int count) {
    const int tid = tid_l();
    PG8_LAS float* tile = (PG8_LAS float*)lds;
    const int lk = tid >> 4, ln4 = (tid & 15) * 4, on = tid >> 3, oks = (tid & 7) * 16;
    f32x4 c0[4], c1[4]; TileDesc d0, d1;
    if (count > 0) { d0 = tile_desc(P, Tbase);
#pragma unroll
        for (int i = 0; i < 4; ++i) c0[i] = *(const f32x4*)(d0.src + (size_t)(lk + 32 * i) * d0.srcN + ln4); }
    if (count > 1) { d1 = tile_desc(P, Tbase + stride);
#pragma unroll
        for (int i = 0; i < 4; ++i) c1[i] = *(const f32x4*)(d1.src + (size_t)(lk + 32 * i) * d1.srcN + ln4); }
    for (int k = 0; k < count; ++k) {
        f32x4 c2[4]; TileDesc d2;
        if (k + 2 < count) { d2 = tile_desc(P, Tbase + (k + 2) * stride);
#pragma unroll
            for (int i = 0; i < 4; ++i) c2[i] = *(const f32x4*)(d2.src + (size_t)(lk + 32 * i) * d2.srcN + ln4); }
#pragma unroll
        for (int i = 0; i < 4; ++i) { const int kk = lk + 32 * i; tile[kk * 65 + ln4 + 0] = c0[i][0]; tile[kk * 65 + ln4 + 1] = c0[i][1]; tile[kk * 65 + ln4 + 2] = c0[i][2]; tile[kk * 65 + ln4 + 3] = c0[i][3]; }
        __syncthreads();
        u32x4 o0, o1;
        o0.x = pk2(tile[(oks + 0) * 65 + on], tile[(oks + 1) * 65 + on]); o0.y = pk2(tile[(oks + 2) * 65 + on], tile[(oks + 3) * 65 + on]);
        o0.z = pk2(tile[(oks + 4) * 65 + on], tile[(oks + 5) * 65 + on]); o0.w = pk2(tile[(oks + 6) * 65 + on], tile[(oks + 7) * 65 + on]);
        o1.x = pk2(tile[(oks + 8) * 65 + on], tile[(oks + 9) * 65 + on]); o1.y = pk2(tile[(oks + 10) * 65 + on], tile[(oks + 11) * 65 + on]);
        o1.z = pk2(tile[(oks + 12) * 65 + on], tile[(oks + 13) * 65 + on]); o1.w = pk2(tile[(oks + 14) * 65 + on], tile[(oks + 15) * 65 + on]);
        bf16_t* dp = d0.dst + (size_t)on * d0.dstK + oks;
        *(u32x4*)dp = o0; *(u32x4*)(dp + 8) = o1;
        __syncthreads();
        d0 = d1; d1 = d2;
#pragma unroll
        for (int i = 0; i < 4; ++i) { c0[i] = c1[i]; c1[i] = c2[i]; }
    }
}
DI void filler_phase(CP P, int slot, LP lds) {
    const int bid = bid_l();
    if (gridDim.x != 256) return;
    if (slot < 2) { if (bid >= 96) convert_tiles_lin(P, lds, 6016 + slot * 1920 + (bid - 96), 160, 12); }
    else if (slot == 2) { if (bid >= 64) convert_tiles_lin(P, lds, 5248 + (bid - 64), 192, 4); }
    else { if (bid >= 64) convert_tiles_lin(P, lds, 9856 + (bid - 64), 192, 6); }
}
DI void prep_phase(CP P, LP lds) {
    const int tid = tid_l(), bid = bid_l(), G = gridDim.x;
    for (int item = bid; item < 192; item += G) adaln_item(P, item, lds);
    if (bid == G - 1) { float* tab = (float*)(P->ws + WS_ROPE);
        for (int i = tid; i < 64 * 32; i += NTHR) { const int pos = i >> 5, f = i & 31; const float inv = 1.0f / powf(10000.0f, (float)(2 * f) / 64.0f); const float ang = (float)pos * inv;
            tab[2 * i] = cosf(ang); tab[2 * i + 1] = sinf(ang); } }
    PG8_LAS float* tile = (PG8_LAS float*)lds;
    const int lk = tid >> 4, ln4 = (tid & 15) * 4, on = tid >> 3, oks = (tid & 7) * 16;
    int T0 = prep_tile_index(bid, G, 0), T1 = T0 >= 0 ? prep_tile_index(bid, G, 1) : -1;
    f32x4 c0[4], c1[4]; TileDesc d0, d1;
    if (T0 >= 0) { d0 = tile_desc(P, T0);
#pragma unroll
        for (int i = 0; i < 4; ++i) c0[i] = *(const f32x4*)(d0.src + (size_t)(lk + 32 * i) * d0.srcN + ln4); }
    if (T1 >= 0) { d1 = tile_desc(P, T1);
#pragma unroll
        for (int i = 0; i < 4; ++i) c1[i] = *(const f32x4*)(d1.src + (size_t)(lk + 32 * i) * d1.srcN + ln4); }
    for (int k = 0; T0 >= 0; ++k) {
        const int T2 = T1 >= 0 ? prep_tile_index(bid, G, k + 2) : -1;
        f32x4 c2[4]; TileDesc d2;
        if (T2 >= 0) { d2 = tile_desc(P, T2);
#pragma unroll
            for (int i = 0; i < 4; ++i) c2[i] = *(const f32x4*)(d2.src + (size_t)(lk + 32 * i) * d2.srcN + ln4); }
#pragma unroll
        for (int i = 0; i < 4; ++i) { const int kk = lk + 32 * i; tile[kk * 65 + ln4 + 0] = c0[i][0]; tile[kk * 65 + ln4 + 1] = c0[i][1]; tile[kk * 65 + ln4 + 2] = c0[i][2]; tile[kk * 65 + ln4 + 3] = c0[i][3]; }
        __syncthreads();
        u32x4 o0, o1;
        o0.x = pk2(tile[(oks + 0) * 65 + on], tile[(oks + 1) * 65 + on]); o0.y = pk2(tile[(oks + 2) * 65 + on], tile[(oks + 3) * 65 + on]);
        o0.z = pk2(tile[(oks + 4) * 65 + on], tile[(oks + 5) * 65 + on]); o0.w = pk2(tile[(oks + 6) * 65 + on], tile[(oks + 7) * 65 + on]);
        o1.x = pk2(tile[(oks + 8) * 65 + on], tile[(oks + 9) * 65 + on]); o1.y = pk2(tile[(oks + 10) * 65 + on], tile[(oks + 11) * 65 + on]);
        o1.z = pk2(tile[(oks + 12) * 65 + on], tile[(oks + 13) * 65 + on]); o1.w = pk2(tile[(oks + 14) * 65 + on], tile[(oks + 15) * 65 + on]);
        bf16_t* dp = d0.dst + (size_t)on * d0.dstK + oks;
        *(u32x4*)dp = o0; *(u32x4*)(dp + 8) = o1;
        __syncthreads();
        T0 = T1; T1 = T2; d0 = d1; d1 = d2;
#pragma unroll
        for (int i = 0; i < 4; ++i) { c0[i] = c1[i]; c1[i] = c2[i]; }
    }
}
DI void norm_mod_phase(CP P, int l, int which, int nrows, LP lds) {
    const int tid = tid_l(), lane = tid & 63, wave = tid >> 6, gw = bid_l() * 8 + wave, nw = gridDim.x * 8;
    unsigned char* ws = P->ws; float* X = (float*)(ws + WS_X); bf16_t* H = (bf16_t*)(ws + WS_H);
    const bool fin = (gridDim.x == 256) && ((l == 0 && which == 1) || (l == 1 && which == 0));
    PG8_LAS int* tbl = (PG8_LAS int*)lds;
    if (fin) { for (int i = tid; i < 576; i += NTHR) tbl[i] = -1;
        __syncthreads();
        if (tid < 64) { pg8::StaticOrder S; S.init(MT, D, 256, tid); Unit u; if (S.next(2, u)) tbl[u.pm * 8 + u.pn] = tid; }
        __syncthreads(); }
    const float* XPp = (const float*)(ws + WS_XP);
    const float* g = (which ? P->in[I_N2G] : P->in[I_N1G]) + l * D;
#define NM_XROW(r_) ((l == 0 && which == 0) ? ((r_) < NLAT ? P->in[I_X] + (size_t)(r_) * D : P->in[I_CTX] + (size_t)((r_) - NLAT) * D) : X + (size_t)(r_) * D)
    const int rpw = (nrows + nw - 1) / nw, r0 = gw * rpw, r1 = (r0 + rpw) < nrows ? (r0 + rpw) : nrows;
    f32x4 v[8], ga[8], gb[8]; int bcur = -1;
    if (r0 < r1) { const float* xr0 = NM_XROW(r0);
#pragma unroll
        for (int i = 0; i < 8; ++i) v[i] = *(const f32x4*)(xr0 + 4 * lane + 256 * i); }
    for (int r = r0; r < r1; ++r) {
        const int rn = r + 1; f32x4 vn[8];
        if (rn < r1) { const float* xrn = NM_XROW(rn);
#pragma unroll
            for (int i = 0; i < 8; ++i) vn[i] = *(const f32x4*)(xrn + 4 * lane + 256 * i); }
        const int b = r < NLAT ? (r >> 11) : 8;
        if (b != bcur) { bcur = b;
            const float* sh = (const float*)(ws + WS_MOD) + (((size_t)l * 9 + b) * 6 + (which ? 3 : 0)) * D; const float* sc = sh + D;
#pragma unroll
            for (int i = 0; i < 8; ++i) { const int col = 4 * lane + 256 * i; ga[i] = *(const f32x4*)(g + col) * (1.0f + *(const f32x4*)(sc + col)); gb[i] = *(const f32x4*)(sh + col); } }
        float ss = 0.f;
#pragma unroll
        for (int i = 0; i < 8; ++i) {
            if (fin) { const int t = tbl[(r >> 8) * 8 + i];
                if (t >= 0) { const float* xp = XPp + ((size_t)(t * 3) << 16) + (size_t)(r & 255) * 256 + 4 * lane;
                    v[i] += *(const f32x4*)xp + *(const f32x4*)(xp + 65536) + *(const f32x4*)(xp + 131072);
                    *(f32x4*)(X + (size_t)r * D + 4 * lane + 256 * i) = v[i]; } }
            ss += v[i][0] * v[i][0] + v[i][1] * v[i][1] + v[i][2] * v[i][2] + v[i][3] * v[i][3]; }
#pragma unroll
        for (int o = 32; o >= 1; o >>= 1) ss += __shfl_xor(ss, o);
        const float rstd = rsqrtf(ss * (1.0f / D) + EPS);
        if (which == 0 && lane == 0) ((float*)(ws + WS_SSQ))[r] = 0.f;
#pragma unroll
        for (int i = 0; i < 8; ++i) { const int col = 4 * lane + 256 * i;
            const f32x4 h = v[i] * rstd * ga[i] + gb[i]; u32x2 w; w.x = pk2(h[0], h[1]); w.y = pk2(h[2], h[3]);
            *(u32x2*)(H + (size_t)r * D + col) = w; }
#pragma unroll
        for (int i = 0; i < 8; ++i) v[i] = vn[i];
    }
#undef NM_XROW
}
DI void final_norm_phase(CP P) {
    const int tid = tid_l(), lane = tid & 63, wave = tid >> 6, gw = bid_l() * 8 + wave, nw = gridDim.x * 8;
    const float* X = (const float*)(P->ws + WS_X); const float* g = P->in[I_FNG];
    const int rpw = (NLAT + nw - 1) / nw, r0 = gw * rpw, r1 = (r0 + rpw) < NLAT ? (r0 + rpw) : NLAT;
    f32x4 v[8], gg[8];
#pragma unroll
    for (int i = 0; i < 8; ++i) gg[i] = *(const f32x4*)(g + 4 * lane + 256 * i);
    if (r0 < r1) {
#pragma unroll
        for (int i = 0; i < 8; ++i) v[i] = *(const f32x4*)(X + (size_t)r0 * D + 4 * lane + 256 * i); }
    for (int r = r0; r < r1; ++r) {
        const int rn = r + 1; f32x4 vn[8];
        if (rn < r1) {
#pragma unroll
            for (int i = 0; i < 8; ++i) vn[i] = *(const f32x4*)(X + (size_t)rn * D + 4 * lane + 256 * i); }
        float ss = 0.f;
#pragma unroll
        for (int i = 0; i < 8; ++i) ss += v[i][0] * v[i][0] + v[i][1] * v[i][1] + v[i][2] * v[i][2] + v[i][3] * v[i][3];
#pragma unroll
        for (int o = 32; o >= 1; o >>= 1) ss += __shfl_xor(ss, o);
        const float rstd = rsqrtf(ss * (1.0f / D) + EPS);
#pragma unroll
        for (int i = 0; i < 8; ++i) __builtin_nontemporal_store(v[i] * rstd * gg[i], (f32x4*)(P->out + (size_t)r * D + 4 * lane + 256 * i));
#pragma unroll
        for (int i = 0; i < 8; ++i) v[i] = vn[i];
    }
}
DI void qk_phase(CP P, int l) {
    const int tid = tid_l(), lane = tid & 63, wave = tid >> 6, j = lane & 15, grp = lane >> 4;
    unsigned char* ws = P->ws; bf16_t* Pb = (bf16_t*)(ws + WS_P); const float* tab = (const float*)(ws + WS_ROPE);
    const int nrows = MT, nw = gridDim.x * 8;
    float qg[8], kg[8];
#pragma unroll
    for (int e = 0; e < 8; ++e) { qg[e] = P->in[I_QNG][l * 128 + 8 * j + e] * QSCALE; kg[e] = P->in[I_KNG][l * 128 + 8 * j + e]; }
    const bool first = (j & 4) == 0;
    for (int row = bid_l() * 8 + wave; row < nrows; row += nw) {
        const bool lat = row < NLAT; const bool qrow = lat || l == 0;
        float cs[8], sn[8];
        if (lat) { const int t = row & 2047, pos = (j & 8) ? (t & 63) : (t >> 6); const float* tp = tab + (size_t)(pos * 32 + 8 * (j & 3)) * 2;
            const f32x4 t0 = *(const f32x4*)tp, t1 = *(const f32x4*)(tp + 4), t2 = *(const f32x4*)(tp + 8), t3 = *(const f32x4*)(tp + 12);
            cs[0] = t0[0]; sn[0] = t0[1]; cs[1] = t0[2]; sn[1] = t0[3]; cs[2] = t1[0]; sn[2] = t1[1]; cs[3] = t1[2]; sn[3] = t1[3];
            cs[4] = t2[0]; sn[4] = t2[1]; cs[5] = t2[2]; sn[5] = t2[3]; cs[6] = t3[0]; sn[6] = t3[1]; cs[7] = t3[2]; sn[7] = t3[3]; }
        else {
#pragma unroll
            for (int e = 0; e < 8; ++e) { cs[e] = 1.f; sn[e] = 0.f; } }
        bf16_t* rp = Pb + (size_t)row * INW + 8 * j;
        u32x4 raw[3]; const bool kact = grp < 2;
        if (qrow) { raw[0] = *(const u32x4*)(rp + grp * 128); raw[1] = *(const u32x4*)(rp + (4 + grp) * 128); }
        const bool kpart = (l == 1 && !lat);
        float kx[8];
        if (kpart) { if (kact) { const float* kp = (const float*)(ws + WS_KVP) + (size_t)(row - NLAT) * 512 + grp * 128 + 8 * j;
                f32x4 a0 = *(const f32x4*)kp, a1 = *(const f32x4*)(kp + 4);
#pragma unroll
                for (int q = 1; q < 4; ++q) { a0 += *(const f32x4*)(kp + (size_t)q * NCTX * 512); a1 += *(const f32x4*)(kp + (size_t)q * NCTX * 512 + 4); }
                kx[0] = a0[0]; kx[1] = a0[1]; kx[2] = a0[2]; kx[3] = a0[3]; kx[4] = a1[0]; kx[5] = a1[1]; kx[6] = a1[2]; kx[7] = a1[3]; }
            else {
#pragma unroll
                for (int e = 0; e < 8; ++e) kx[e] = 0.f; } }
        else raw[2] = *(const u32x4*)(rp + 1024 + (kact ? grp : 0) * 128);
#pragma unroll
        for (int pass = 0; pass < 3; ++pass) {
            if (pass < 2 && !qrow) continue;
            float x[8];
            if (pass == 2 && kpart) {
#pragma unroll
                for (int e = 0; e < 8; ++e) x[e] = kx[e]; }
            else { const u32x4 rw = raw[pass]; x[0] = bf_lo(rw.x); x[1] = bf_hi(rw.x); x[2] = bf_lo(rw.y); x[3] = bf_hi(rw.y); x[4] = bf_lo(rw.z); x[5] = bf_hi(rw.z); x[6] = bf_lo(rw.w); x[7] = bf_hi(rw.w); }
            float ss = 0.f;
#pragma unroll
            for (int e = 0; e < 8; ++e) ss += x[e] * x[e];
            ss += __shfl_xor(ss, 1); ss += __shfl_xor(ss, 2); ss += __shfl_xor(ss, 4); ss += __shfl_xor(ss, 8);
            const float rstd = rsqrtf(ss * (1.0f / 128.0f) + EPS);
            float y[8], yp[8];
#pragma unroll
            for (int e = 0; e < 8; ++e) y[e] = x[e] * rstd * (pass < 2 ? qg[e] : kg[e]);
#pragma unroll
            for (int e = 0; e < 8; ++e) yp[e] = __shfl_xor(y[e], 4);
#pragma unroll
            for (int e = 0; e < 8; ++e) y[e] = first ? (y[e] * cs[e] - yp[e] * sn[e]) : (y[e] * cs[e] + yp[e] * sn[e]);
            u32x4 w; w.x = pk2(y[0], y[1]); w.y = pk2(y[2], y[3]); w.z = pk2(y[4], y[5]); w.w = pk2(y[6], y[7]);
            if (pass == 0) *(u32x4*)(rp + grp * 128) = w;
            else if (pass == 1) *(u32x4*)(rp + (4 + grp) * 128) = w;
            else if (kact) *(u32x4*)(rp + 1024 + grp * 128) = w;
        }
    }
}
DI void vt_phase(CP P, int l, LP lds) {
    const int tid = tid_l(); unsigned char* ws = P->ws; const bf16_t* Pb = (const bf16_t*)(ws + WS_P);
    for (int it = (bid_l() + (int)((gridDim.x * 3) >> 2)) % (int)gridDim.x; it < 288; it += gridDim.x) {
        int rowbase, LV, t0, b; bf16_t* dst;
        if (it < 256) { b = it >> 5; t0 = (it & 31) * 64; rowbase = b * SEQ + t0; LV = SEQ; dst = (bf16_t*)(ws + WS_VTL) + (size_t)b * 2 * 128 * SEQ + t0; }
        else { const int i2 = it - 256; b = i2 >> 2; t0 = (i2 & 3) * 64; rowbase = NLAT + b * CTXL + t0; LV = CTXL; dst = (bf16_t*)(ws + WS_VTC) + (size_t)b * 2 * 128 * CTXL + t0; }
#pragma unroll
        for (int i = 0; i < 4; ++i) { const int idx = tid + 512 * i, row = idx >> 5, c16 = idx & 31;
            u32x4 v;
            if (l == 1 && it >= 256) {
                const float* vp = (const float*)(ws + WS_KVP) + (size_t)(rowbase - NLAT + row) * 512 + 256 + 8 * c16;
                f32x4 a0 = *(const f32x4*)vp, a1 = *(const f32x4*)(vp + 4);
#pragma unroll
                for (int q = 1; q < 4; ++q) { a0 += *(const f32x4*)(vp + (size_t)q * NCTX * 512); a1 += *(const f32x4*)(vp + (size_t)q * NCTX * 512 + 4); }
                v.x = pk2(a0[0], a0[1]); v.y = pk2(a0[2], a0[3]); v.z = pk2(a1[0], a1[1]); v.w = pk2(a1[2], a1[3]);
            } else v = *(const u32x4*)(Pb + (size_t)(rowbase + row) * INW + 1280 + 8 * c16);
            *(PG8_LAS u32x4*)(lds + row * 528 + c16 * 16) = v; }
        __syncthreads();
#pragma unroll
        for (int i = 0; i < 4; ++i) { const int idx = tid + 512 * i, col = idx >> 3, ts = idx & 7;
            unsigned short e[8];
#pragma unroll
            for (int k = 0; k < 8; ++k) e[k] = *(const PG8_LAS unsigned short*)(lds + (8 * ts + k) * 528 + col * 2);
            u32x4 w; w.x = e[0] | ((unsigned)e[1] << 16); w.y = e[2] | ((unsigned)e[3] << 16); w.z = e[4] | ((unsigned)e[5] << 16); w.w = e[6] | ((unsigned)e[7] << 16);
            *(u32x4*)(dst + (size_t)col * LV + 8 * ts) = w; }
        __syncthreads();
    }
}
#define MFMA16(a, b, c) __builtin_amdgcn_mfma_f32_16x16x32_bf16((a), (b), (c), 0, 0, 0)
#define MFMA32(a, b, c) __builtin_amdgcn_mfma_f32_32x32x16_bf16((a), (b), (c), 0, 0, 0)
DI void pool_phase(CP P, int l, LP lds) {
    const int tid = tid_l(), lane = tid & 63, wave = tid >> 6; unsigned char* ws = P->ws;
    const bf16_t* Pb = (const bf16_t*)(ws + WS_P); bf16_t* MIX = (bf16_t*)(ws + WS_MIX);
    const LP raw = lds, Yl = lds + 144 * 272, Wt = lds + 144 * 272 + 128 * 272;
    const int nitems = (l == 0 ? 144 : 128) * 4; int wgi = -1;
    for (int it = bid_l(); it < nitems; it += gridDim.x) {
        const int gi = it & 3, tile = it >> 2, row0 = tile * 128;
        const int L = row0 < NLAT ? SEQ : CTXL, s0 = row0 < NLAT ? (row0 & ~(SEQ - 1)) : NLAT + ((row0 - NLAT) & ~(CTXL - 1)), tpos0 = row0 - s0;
        const int w = 2 << gi;
        { u32x4 rv_[5]; bool ok_[5];
#pragma unroll
          for (int q = 0; q < 5; ++q) { const int i = tid + q * NTHR, rr = i >> 4, c = i & 15, tp = tpos0 - 8 + rr; ok_[q] = (i < 144 * 16) && tp >= 0 && tp < L;
              if (ok_[q]) rv_[q] = *(const u32x4*)(Pb + (size_t)(s0 + tp) * INW + 1536 + gi * 128 + c * 8); }
#pragma unroll
          for (int q = 0; q < 5; ++q) { const int i = tid + q * NTHR, rr = i >> 4, c = i & 15; if (ok_[q]) *(PG8_LAS u32x4*)(raw + rr * 272 + c * 16) = rv_[q]; } }
        if (gi != wgi) { wgi = gi;
            const float* pw = P->in[I_POOLW] + ((size_t)l * 4 + gi) * 128 * 128;
            f32x4 wv_[8];
#pragma unroll
            for (int q = 0; q < 8; ++q) { const int i = tid + q * NTHR; wv_[q] = *(const f32x4*)(pw + (i >> 5) * 128 + (i & 31) * 4); }
#pragma unroll
            for (int q = 0; q < 8; ++q) { const int i = tid + q * NTHR, c = i >> 5, d4 = (i & 31) * 4;
#pragma unroll
                for (int e = 0; e < 4; ++e) *(PG8_LAS unsigned short*)(Wt + (d4 + e) * 272 + c * 2) = (unsigned short)(pk2(wv_[q][e], 0.f) & 0xffffu); } }
        __syncthreads();
        { const int t = tid >> 2, cs = (tid & 3) * 32, tp = tpos0 + t;
          int lo = tp - (w >> 1), hi = lo + w; lo = lo < 0 ? 0 : lo; hi = hi > L ? L : hi; const float inv = 1.0f / (float)(hi - lo);
#pragma unroll
          for (int q = 0; q < 4; ++q) { float sum[8];
#pragma unroll
              for (int e = 0; e < 8; ++e) sum[e] = 0.f;
              for (int tt = lo; tt < hi; ++tt) { const u32x4 v = *(const PG8_LAS u32x4*)(raw + (tt - tpos0 + 8) * 272 + (cs + 8 * q) * 2);
                  sum[0] += bf_lo(v.x); sum[1] += bf_hi(v.x); sum[2] += bf_lo(v.y); sum[3] += bf_hi(v.y); sum[4] += bf_lo(v.z); sum[5] += bf_hi(v.z); sum[6] += bf_lo(v.w); sum[7] += bf_hi(v.w); }
              const u32x4 sv = *(const PG8_LAS u32x4*)(raw + (t + 8) * 272 + (cs + 8 * q) * 2);
              u32x4 o; o.x = pk2(sum[0] * inv - bf_lo(sv.x), sum[1] * inv - bf_hi(sv.x)); o.y = pk2(sum[2] * inv - bf_lo(sv.y), sum[3] * inv - bf_hi(sv.y));
              o.z = pk2(sum[4] * inv - bf_lo(sv.z), sum[5] * inv - bf_hi(sv.z)); o.w = pk2(sum[6] * inv - bf_lo(sv.w), sum[7] * inv - bf_hi(sv.w));
              *(PG8_LAS u32x4*)(Yl + t * 272 + (cs + 8 * q) * 2) = o; } }
        __syncthreads();
        { f32x4 acc[8];
#pragma unroll
          for (int dt = 0; dt < 8; ++dt) acc[dt] = (f32x4){0.f, 0.f, 0.f, 0.f};
          const int li = lane & 15, lq = lane >> 4;
#pragma unroll
          for (int ks = 0; ks < 4; ++ks) { const bf16x8 bfr = *(const PG8_LAS bf16x8*)(Yl + (16 * wave + li) * 272 + (32 * ks + 8 * lq) * 2);
#pragma unroll
              for (int dt = 0; dt < 8; ++dt) { const bf16x8 afr = *(const PG8_LAS bf16x8*)(Wt + (16 * dt + li) * 272 + (32 * ks + 8 * lq) * 2); acc[dt] = MFMA16(afr, bfr, acc[dt]); } }
          const int token = row0 + 16 * wave + li; const float* psc = P->in[I_POOLS] + l * 512 + gi * 128 + 4 * lq;
          f32x4 sc_[8];
#pragma unroll
          for (int dt = 0; dt < 8; ++dt) sc_[dt] = *(const f32x4*)(psc + 16 * dt);
#pragma unroll
          for (int dt = 0; dt < 8; ++dt) { const f32x4 o = acc[dt] * sc_[dt]; u32x2 wv; wv.x = pk2(o[0], o[1]); wv.y = pk2(o[2], o[3]);
              *(u32x2*)(MIX + (size_t)token * D + 1024 + gi * 128 + 16 * dt + 4 * lq) = wv; } }
        __syncthreads();
    }
}
DI void sgu_phase(CP P, int l, LP lds) {
    const int tid = tid_l(), lane = tid & 63, wave = tid >> 6; unsigned char* ws = P->ws;
    const bf16_t* Pb = (const bf16_t*)(ws + WS_P); bf16_t* MIX = (bf16_t*)(ws + WS_MIX);
    const LP Vt = lds, Wl = lds + 128 * 272;
    const int nitems = (l == 0 ? 144 : 128) * 4; int whh = -1;
    for (int it = (bid_l() + (int)(gridDim.x >> 1)) % (int)gridDim.x; it < nitems; it += gridDim.x) {
        const int hh = it & 3, chunk = it >> 2, row0 = chunk * 128;
        const int q = tid >> 2, part = tid & 3;
        const bf16_t* gr = Pb + (size_t)(row0 + q) * INW + 2560;
        const float ss = ((const float*)(ws + WS_SSQ))[row0 + q];
        const float rstd = rsqrtf(ss * (1.0f / 512.0f) + EPS);
        const float* gn = P->in[I_SGUNG] + l * 512 + hh * 128 + part * 32;
#pragma unroll
        for (int i = 0; i < 4; ++i) { const u32x4 v = *(const u32x4*)(gr + hh * 128 + part * 32 + 8 * i);
            const f32x4 a = (f32x4){bf_lo(v.x), bf_hi(v.x), bf_lo(v.y), bf_hi(v.y)}, b = (f32x4){bf_lo(v.z), bf_hi(v.z), bf_lo(v.w), bf_hi(v.w)};
            const f32x4 g0 = *(const f32x4*)(gn + 8 * i), g1 = *(const f32x4*)(gn + 8 * i + 4);
            const int c0 = part * 32 + 8 * i;
#pragma unroll
            for (int e = 0; e < 4; ++e) { *(PG8_LAS unsigned short*)(Vt + (c0 + e) * 272 + q * 2) = (unsigned short)(pk2(a[e] * rstd * g0[e], 0.f) & 0xffffu);
                                          *(PG8_LAS unsigned short*)(Vt + (c0 + 4 + e) * 272 + q * 2) = (unsigned short)(pk2(b[e] * rstd * g1[e], 0.f) & 0xffffu); } }
        if (hh != whh) { whh = hh;
            const float* sw = P->in[I_SGUW] + ((size_t)l * 4 + hh) * 128 * 128;
            f32x4 wv_[8];
#pragma unroll
            for (int q = 0; q < 8; ++q) { const int i = tid + q * NTHR; wv_[q] = *(const f32x4*)(sw + (i >> 5) * 128 + (i & 31) * 4); }
#pragma unroll
            for (int q = 0; q < 8; ++q) { const int i = tid + q * NTHR, pp = i >> 5, q4 = (i & 31) * 4;
                u32x2 o; o.x = pk2(wv_[q][0], wv_[q][1]); o.y = pk2(wv_[q][2], wv_[q][3]); *(PG8_LAS u32x2*)(Wl + pp * 272 + q4 * 2) = o; } }
        __syncthreads();
        { f32x4 acc[8];
#pragma unroll
          for (int ct = 0; ct < 8; ++ct) acc[ct] = (f32x4){0.f, 0.f, 0.f, 0.f};
          const int li = lane & 15, lq = lane >> 4;
#pragma unroll
          for (int ks = 0; ks < 4; ++ks) { const bf16x8 wfr = *(const PG8_LAS bf16x8*)(Wl + (16 * wave + li) * 272 + (32 * ks + 8 * lq) * 2);
#pragma unroll
              for (int ct = 0; ct < 8; ++ct) { const bf16x8 vfr = *(const PG8_LAS bf16x8*)(Vt + (16 * ct + li) * 272 + (32 * ks + 8 * lq) * 2); acc[ct] = MFMA16(vfr, wfr, acc[ct]); } }
          const int pl = 16 * wave + li, token = row0 + pl; const float bias = P->in[I_SGUB][(l * 4 + hh) * 128 + pl];
          const bf16_t* up = Pb + (size_t)token * INW + 2048 + hh * 128 + 4 * lq;
          u32x2 uv_[8];
#pragma unroll
          for (int ct = 0; ct < 8; ++ct) uv_[ct] = *(const u32x2*)(up + 16 * ct);
#pragma unroll
          for (int ct = 0; ct < 8; ++ct) { const u32x2 uv = uv_[ct]; const f32x4 ug = (f32x4){bf_lo(uv.x), bf_hi(uv.x), bf_lo(uv.y), bf_hi(uv.y)};
              const f32x4 o = ug * (acc[ct] + bias); u32x2 wv; wv.x = pk2(o[0], o[1]); wv.y = pk2(o[2], o[3]);
              *(u32x2*)(MIX + (size_t)token * D + 1536 + hh * 128 + 16 * ct + 4 * lq) = wv; } }
        __syncthreads();
    }
}
DI void attn_phase(CP P, int l, LP lds) {
    const int tid = tid_l(), lane = tid & 63, wave = tid >> 6, r = lane & 31, h = lane >> 5; unsigned char* ws = P->ws;
    const bf16_t* Pb = (const bf16_t*)(ws + WS_P); bf16_t* MIX = (bf16_t*)(ws + WS_MIX);
    const bf16_t* VTL = (const bf16_t*)(ws + WS_VTL); const bf16_t* VTC = (const bf16_t*)(ws + WS_VTC);
    constexpr int ATT_BUF = 64 * 272 + 128 * 144;
    const LP Kl = lds, Vl = lds + 64 * 272;
    const int nitems = l == 0 ? 576 : 512;
    for (int it = bid_l(); it < nitems; it += gridDim.x) {
        const bool isctx = it >= 512; int b, n, kh, hp;
        if (!isctx) { hp = it & 1; kh = (it >> 1) & 1; n = (it >> 2) & 15; b = it >> 6; } else { const int i2 = it - 512; hp = i2 & 1; kh = (i2 >> 1) & 1; n = (i2 >> 2) & 1; b = i2 >> 3; }
        const int qrow0 = isctx ? NLAT + b * CTXL + n * 128 : b * SEQ + n * 128;
        const int hq = kh * 4 + hp * 2 + (wave >> 2), qsub = wave & 3, myrow = qrow0 + qsub * 32 + r;
        bf16x8 qf[8];
#pragma unroll
        for (int ks = 0; ks < 8; ++ks) qf[ks] = *(const bf16x8*)(Pb + (size_t)myrow * INW + hq * 128 + 16 * ks + 8 * h);
        const int kb_lo = n > 0 ? n - 1 : 0, kb_hi = n < 15 ? n + 1 : 15;
        const int nband = isctx ? 0 : (kb_hi - kb_lo + 1) * 2, nch = nband + 4;
        float m = P->in[I_SINK][l * 8 + hq] * LOG2E, lsum = 1.0f;
        f32x16 O[4];
#pragma unroll
        for (int dt = 0; dt < 4; ++dt)
#pragma unroll
            for (int i = 0; i < 16; ++i) O[dt][i] = 0.f;
        u32x4 pre[4];
        const bf16_t* Kc_base = Pb + (size_t)(NLAT + b * CTXL) * INW + 1024 + kh * 128;
        const bf16_t* Kb_base = Pb + (size_t)(b * SEQ) * INW + 1024 + kh * 128;
        const bf16_t* Vc_base = VTC + (size_t)(b * 2 + kh) * 128 * CTXL;
        const bf16_t* Vb_base = VTL + (size_t)(b * 2 + kh) * 128 * SEQ;
#define ATT_LOAD(c) do { const bool band_ = (c) < nband; const int key0_ = band_ ? kb_lo * 128 + (c) * 64 : ((c) - nband) * 64; \
            const bf16_t* kb_ = band_ ? Kb_base : Kc_base; const bf16_t* vb_ = band_ ? Vb_base : Vc_base; const int lv_ = band_ ? SEQ : CTXL; \
            _Pragma("unroll") for (int i_ = 0; i_ < 2; ++i_) { const int p_ = tid + 512 * i_; \
                pre[i_] = *(const u32x4*)(kb_ + (size_t)(key0_ + (p_ >> 4)) * INW + (p_ & 15) * 8); \
                pre[2 + i_] = *(const u32x4*)(vb_ + (size_t)(p_ >> 3) * lv_ + key0_ + (p_ & 7) * 8); } } while (0)
        ATT_LOAD(0);
        __syncthreads();
#pragma unroll
        for (int i = 0; i < 2; ++i) { const int p = tid + 512 * i; *(PG8_LAS u32x4*)(Kl + (p >> 4) * 272 + (p & 15) * 16) = pre[i]; *(PG8_LAS u32x4*)(Vl + (p >> 3) * 144 + (p & 7) * 16) = pre[2 + i]; }
        __syncthreads();
        for (int c = 0; c < nch; ++c) {
            const LP Kc = Kl + (c & 1) * ATT_BUF, Vc = Vl + (c & 1) * ATT_BUF;
            if (c + 1 < nch) ATT_LOAD(c + 1);
            bool skip = false; int kblk = n;
            if (c < nband) { kblk = kb_lo + (c >> 1);
                if (kblk < n) skip = ((c & 1) == 0) && (qsub >= 2);
                else if (kblk > n) skip = ((c & 1) == 1) && (qsub < 2); }
            if (!skip) {
            f32x16 S0, S1;
#pragma unroll
            for (int i = 0; i < 16; ++i) { S0[i] = 0.f; S1[i] = 0.f; }
#pragma unroll
            for (int ks = 0; ks < 8; ++ks) { const bf16x8 k0 = *(const PG8_LAS bf16x8*)(Kc + r * 272 + (16 * ks + 8 * h) * 2), k1 = *(const PG8_LAS bf16x8*)(Kc + (32 + r) * 272 + (16 * ks + 8 * h) * 2);
                S0 = MFMA32(k0, qf[ks], S0); S1 = MFMA32(k1, qf[ks], S1); }
            const bool allvalid = (kblk < n) ? (((c & 1) == 1) && (qsub < 2)) : (((c & 1) == 0) && (qsub >= 2));
            if (kblk != n && !allvalid) { const int qi = n * 128 + qsub * 32 + r, kj0 = kblk * 128 + (c & 1) * 64 + 4 * h;
#pragma unroll
                for (int i = 0; i < 16; ++i) { const int kj = kj0 + (i & 3) + 8 * (i >> 2); int dd = qi - kj; dd = dd < 0 ? -dd : dd;
                    if (dd > 128) S0[i] = -1e30f; int d2 = qi - (kj + 32); d2 = d2 < 0 ? -d2 : d2; if (d2 > 128) S1[i] = -1e30f; } }
            float cmax = S0[0];
#pragma unroll
            for (int i = 1; i < 16; ++i) cmax = fmaxf(cmax, S0[i]);
#pragma unroll
            for (int i = 0; i < 16; ++i) cmax = fmaxf(cmax, S1[i]);
            { const auto r_ = __builtin_amdgcn_permlane32_swap(__float_as_uint(cmax), __float_as_uint(cmax), false, false); cmax = fmaxf(__uint_as_float(r_[0]), __uint_as_float(r_[1])); }
            const bool grew = cmax > m + 8.0f; const float mnew = grew ? cmax : m, alpha = __builtin_amdgcn_exp2f(m - mnew); m = mnew;
            float rs = 0.f;
#pragma unroll
            for (int i = 0; i < 16; ++i) { S0[i] = __builtin_amdgcn_exp2f(S0[i] - mnew); S1[i] = __builtin_amdgcn_exp2f(S1[i] - mnew); rs += S0[i] + S1[i]; }
            { const auto r_ = __builtin_amdgcn_permlane32_swap(__float_as_uint(rs), __float_as_uint(rs), false, false); rs = __uint_as_float(r_[0]) + __uint_as_float(r_[1]); }
            lsum = lsum * alpha + rs;
            if (__any(grew)) {
#pragma unroll
                for (int dt = 0; dt < 4; ++dt)
#pragma unroll
                    for (int i = 0; i < 16; ++i) O[dt][i] *= alpha; }
            bf16x8 pf[2][2];
#pragma unroll
            for (int s = 0; s < 2; ++s) { u32x4 a, bq;
                a.x = pk2(S0[8 * s + 0], S0[8 * s + 1]); a.y = pk2(S0[8 * s + 2], S0[8 * s + 3]); a.z = pk2(S0[8 * s + 4], S0[8 * s + 5]); a.w = pk2(S0[8 * s + 6], S0[8 * s + 7]);
                bq.x = pk2(S1[8 * s + 0], S1[8 * s + 1]); bq.y = pk2(S1[8 * s + 2], S1[8 * s + 3]); bq.z = pk2(S1[8 * s + 4], S1[8 * s + 5]); bq.w = pk2(S1[8 * s + 6], S1[8 * s + 7]);
                pf[0][s] = __builtin_bit_cast(bf16x8, a); pf[1][s] = __builtin_bit_cast(bf16x8, bq); }
#pragma unroll
            for (int dt = 0; dt < 4; ++dt)
#pragma unroll
                for (int kt = 0; kt < 2; ++kt)
#pragma unroll
                    for (int s = 0; s < 2; ++s) { const LP vp = Vc + (32 * dt + r) * 144 + (32 * kt + 16 * s + 4 * h) * 2;
                        const u32x2 lo = *(const PG8_LAS u32x2*)vp, hi = *(const PG8_LAS u32x2*)(vp + 16);
                        u32x4 vv; vv.x = lo.x; vv.y = lo.y; vv.z = hi.x; vv.w = hi.y;
                        O[dt] = MFMA32(__builtin_bit_cast(bf16x8, vv), pf[kt][s], O[dt]); }
            }
            if (c + 1 < nch) {
                const LP Kn = Kl + ((c + 1) & 1) * ATT_BUF, Vn = Vl + ((c + 1) & 1) * ATT_BUF;
#pragma unroll
                for (int i = 0; i < 2; ++i) { const int p = tid + 512 * i; *(PG8_LAS u32x4*)(Kn + (p >> 4) * 272 + (p & 15) * 16) = pre[i]; *(PG8_LAS u32x4*)(Vn + (p >> 3) * 144 + (p & 7) * 16) = pre[2 + i]; }
            }
            __syncthreads();
        }
#undef ATT_LOAD
        const float inv = 1.0f / lsum;
        bf16_t* op = MIX + (size_t)myrow * D + hq * 128 + 4 * h;
#pragma unroll
        for (int dt = 0; dt < 4; ++dt)
#pragma unroll
            for (int g = 0; g < 4; ++g) { u32x2 wv; wv.x = pk2(O[dt][4 * g] * inv, O[dt][4 * g + 1] * inv); wv.y = pk2(O[dt][4 * g + 2] * inv, O[dt][4 * g + 3] * inv);
                *(u32x2*)(op + 32 * dt + 8 * g) = wv; }
    }
}
DI void fixup_phase(CP P, int l) {
    unsigned char* ws = P->ws; const float* hb = (const float*)(ws + WS_HB); bf16_t* act = (bf16_t*)(ws + WS_ACT);
    const float* cw = P->in[I_CONVW] + (size_t)l * 3 * NUP; const float* cb = P->in[I_CONVB] + (size_t)l * NUP;
    const int nbd = l == 0 ? 128 : 120, total = nbd * (DFF / 4);
    for (int i = bid_l() * NTHR + tid_l(); i < total; i += gridDim.x * NTHR) {
        const int bd = i / (DFF / 4), ch = (i % (DFF / 4)) * 4;
        int blkB; if (bd < 120) { const int b = bd / 15, k = bd % 15 + 1; blkB = b * 16 + k; } else { blkB = 128 + 2 * (bd - 120) + 1; }
        const int blkA = blkB - 1, pn = ch >> 7, cl = ch & 127, ig = pn * 256 + cl, iv = ig + 128;
        const float* A2 = hb + ((size_t)blkA * 4 + 2) * NUP; const float* A3 = A2 + NUP; const float* B0 = hb + ((size_t)blkB * 4) * NUP; const float* B1 = B0 + NUP;
        const f32x4 gm2 = *(const f32x4*)(A2 + ig), gm1 = *(const f32x4*)(A3 + ig), g0 = *(const f32x4*)(B0 + ig), g1 = *(const f32x4*)(B1 + ig);
        const f32x4 vm2 = *(const f32x4*)(A2 + iv), vm1 = *(const f32x4*)(A3 + iv), v0 = *(const f32x4*)(B0 + iv), v1 = *(const f32x4*)(B1 + iv);
        const f32x4 w0g = *(const f32x4*)(cw + ch), w1g = *(const f32x4*)(cw + NUP + ch), w2g = *(const f32x4*)(cw + 2 * NUP + ch), bg = *(const f32x4*)(cb + ch);
        const f32x4 w0v = *(const f32x4*)(cw + DFF + ch), w1v = *(const f32x4*)(cw + NUP + DFF + ch), w2v = *(const f32x4*)(cw + 2 * NUP + DFF + ch), bv = *(const f32x4*)(cb + DFF + ch);
        const f32x4 cgA = bg + w0g * gm2 + w1g * gm1 + w2g * g0, cvA = bv + w0v * vm2 + w1v * vm1 + w2v * v0;
        const f32x4 cgB = bg + w0g * gm1 + w1g * g0 + w2g * g1, cvB = bv + w0v * vm1 + w1v * v0 + w2v * v1;
        f32x4 oA, oB;
#pragma unroll
        for (int e = 0; e < 4; ++e) { oA[e] = silu_f(cgA[e]) * cvA[e]; oB[e] = silu_f(cgB[e]) * cvB[e]; }
        u32x2 wa, wb; wa.x = pk2(oA[0], oA[1]); wa.y = pk2(oA[2], oA[3]); wb.x = pk2(oB[0], oB[1]); wb.y = pk2(oB[2], oB[3]);
        const size_t rowB = (size_t)blkB * 128;
        *(u32x2*)(act + (rowB - 1) * DFF + ch) = wa; *(u32x2*)(act + rowB * DFF + ch) = wb;
    }
}
#ifndef GEMM_ALIGN
#define GEMM_ALIGN true
#endif
#ifndef GEMM_SP2
#define GEMM_SP2 true
#endif
#define GEMM_CALL(EpiT, g, S, E) pg8::gemm_phase<EpiT, pg8::StaticOrder, GEMM_ALIGN, GEMM_SP2>(lds, g, S, E)
DI void gemm_in_phase(CP P, int l, LP lds, bool subset = false) {
    unsigned char* ws = P->ws; const bf16_t* H = (const bf16_t*)(ws + WS_H); const bf16_t* W = (const bf16_t*)(ws + WS_WIN + l * SZ_WIN); bf16_t* Pb = (bf16_t*)(ws + WS_P);
    { pg8::Gemm g; EpiP E; E.O = Pb; E.ldc = INW; g.A = H; g.Bt = W; g.M = l == 0 ? MT : NLAT; g.N = INW; g.K = D; E.row_off = 0; E.col_off = 0; E.gelu_from_pn = 8; E.ssq = (float*)(ws + WS_SSQ);
      pg8::StaticOrder S; S.init(g.M, g.N, gridDim.x, bid_l()); S.nkt = g.K / 64;
      if (subset) { const int b_ = bid_l(); if ((b_ >> 3) & 1) { S.init(g.M, g.N, 128, 0); S.nwg = 0; } else S.init(g.M, g.N, 128, (b_ >> 4) * 8 + (b_ & 7)); S.nkt = g.K / 64; }
      GEMM_CALL(EpiP, g, S, E); }
    if (l == 1) {
        pg8::Gemm g; g.A = H + (size_t)NLAT * D; g.Bt = W + (size_t)1024 * D; g.M = NCTX; g.N = 512; g.K = D;
        EpiKVPart E; E.kvp = (float*)(ws + WS_KVP);
        pg8::StaticOrder S; S.init(g.M, g.N, gridDim.x, bid_l()); S.nkt = g.K / 64; S.split = 1;
        GEMM_CALL(EpiKVPart, g, S, E);
        filler_phase(P, 3, lds);
    }
}
DI void gemm_res_phase(CP P, int l, int which, LP lds) {
    unsigned char* ws = P->ws; float* X = (float*)(ws + WS_X);
    pg8::Gemm g; g.M = l == 0 ? MT : NLAT; g.N = D;
    if (which == 0) { g.A = (const bf16_t*)(ws + WS_MIX); g.Bt = (const bf16_t*)(ws + WS_WOUT + l * SZ_WOUT); g.K = D; }
    else { g.A = (const bf16_t*)(ws + WS_ACT); g.Bt = (const bf16_t*)(ws + WS_WDN + l * SZ_WDN); g.K = DFF; }
    EpiRes E; E.out = X; E.gate = (const float*)(ws + WS_MOD) + ((size_t)l * 9 * 6 + (which ? 5 : 2)) * D;
    if (l == 0 && which == 0) { E.base_lat = P->in[I_X]; E.base_ctx = P->in[I_CTX]; } else { E.base_lat = X; E.base_ctx = X + (size_t)NLAT * D; }
    pg8::StaticOrder S; S.init(g.M, g.N, gridDim.x, bid_l()); S.nkt = g.K / 64; S.split = (gridDim.x == 256 && l == 0) ? 1 : 0;
    E.xpart = (float*)(ws + WS_XP);
    GEMM_CALL(EpiRes, g, S, E);
}
DI void gemm_up_phase(CP P, int l, LP lds) {
    unsigned char* ws = P->ws;
    pg8::Gemm g; g.A = (const bf16_t*)(ws + WS_H); g.Bt = (const bf16_t*)(ws + WS_WUP + l * SZ_WUP); g.M = l == 0 ? MT : NLAT; g.N = NUP; g.K = D;
    EpiConvGlu E; E.act = (bf16_t*)(ws + WS_ACT); E.hb = (float*)(ws + WS_HB); E.cw = P->in[I_CONVW] + (size_t)l * 3 * NUP; E.cb = P->in[I_CONVB] + (size_t)l * NUP;
    pg8::StaticOrder S; S.init(g.M, g.N, gridDim.x, bid_l()); S.nkt = g.K / 64;
    GEMM_CALL(EpiConvGlu, g, S, E);
}
__global__ void __launch_bounds__(NTHR, 2) fwd_kernel(Params Parg) {
    extern __shared__ __attribute__((aligned(16))) unsigned char lds_raw[];
    const LP lds = (LP)lds_raw;
    cg::grid_group grid = cg::this_grid();
    const int lo = Parg.ph_lo, hi = Parg.ph_hi; int ph = 0;
    if (lo < 0) grid.sync();
    volatile PG8_LAS unsigned* xst = (volatile PG8_LAS unsigned*)(lds + 131072);
    if (threadIdx.x < 4) xst[threadIdx.x] = 0u;
    __syncthreads();
    XcdBarrier xbar = xcd_barrier_post((unsigned*)(Parg.ws + WS_BAR), xst);
#ifndef REP_MASK
#define REP_MASK 0u
#endif
#ifndef EXTRA_SYNCS
#define EXTRA_SYNCS 0
#endif
#ifndef PH_MASK
#define PH_MASK 0xffffffffu
#endif
#define PHASE(id, body) do { if (ph >= lo && ph < hi) { if ((PH_MASK >> (id)) & 1u) { auto kp_ = __builtin_amdgcn_kernarg_segment_ptr(); asm volatile("" : "+s"(kp_)); const CP P = (CP)kp_; body; if ((REP_MASK >> (id)) & 1u) { xcd_barrier(xbar); body; } } if (ph + 1 < hi) xcd_barrier(xbar); for (int xs_ = 0; xs_ < EXTRA_SYNCS; ++xs_) xcd_barrier(xbar); } ++ph; } while (0)
    PHASE(0, prep_phase(P, lds));
#pragma nounroll
    for (int l = 0; l < 2; ++l) {
        const int M = l == 0 ? MT : NLAT;
        PHASE(1, norm_mod_phase(P, l, 0, MT, lds));
        do { if (ph >= lo && ph < hi) { { auto kp_ = __builtin_amdgcn_kernarg_segment_ptr(); asm volatile("" : "+s"(kp_)); const CP P = (CP)kp_; gemm_in_phase(P, l, lds); if (l == 0) filler_phase(P, 0, lds); }
#ifdef SUBSET_PROBE
            xcd_barrier(xbar); { auto kp_ = __builtin_amdgcn_kernarg_segment_ptr(); asm volatile("" : "+s"(kp_)); const CP P = (CP)kp_; gemm_in_phase(P, l, lds, true); }
#endif
            if (ph + 1 < hi) xcd_barrier(xbar); } ++ph; } while (0);
        PHASE(3, { if ((PH_MASK >> 11) & 1u) qk_phase(P, l); for (int rp_ = 0; rp_ <= (int)((REP_MASK >> 12) & 1u); ++rp_) vt_phase(P, l, lds); for (int rp_ = 0; rp_ <= (int)((REP_MASK >> 13) & 1u); ++rp_) pool_phase(P, l, lds); for (int rp_ = 0; rp_ <= (int)((REP_MASK >> 14) & 1u); ++rp_) sgu_phase(P, l, lds); });
        PHASE(4, { attn_phase(P, l, lds); if (l == 0) filler_phase(P, 2, lds); });
        PHASE(5, { gemm_res_phase(P, l, 0, lds); });
        PHASE(6, norm_mod_phase(P, l, 1, M, lds));
        PHASE(7, { gemm_up_phase(P, l, lds); if (l == 0) filler_phase(P, 1, lds); });
        PHASE(8, fixup_phase(P, l));
        PHASE(9, { gemm_res_phase(P, l, 1, lds); });
    }
    PHASE(10, final_norm_phase(P));
#undef PHASE
}
constexpr int N_PHASES = 20;

extern "C" void kernel_launch(void* const* d_in, const int* in_sizes, int n_in, void* d_out, int out_size, void* d_ws, size_t ws_size, hipStream_t stream) {
    static int grid = 0;
    if (grid == 0) {
        if (n_in != N_IN || ws_size < WS_END) { fprintf(stderr, "kernel_launch: need %d inputs and >= %zu bytes of workspace; got %d, %zu\n", (int)N_IN, (size_t)WS_END, n_in, ws_size); grid = -1; return; }
        int dev = 0, cus = 0, per_cu = 0;
        if (hipGetDevice(&dev) != hipSuccess || hipDeviceGetAttribute(&cus, hipDeviceAttributeMultiprocessorCount, dev) != hipSuccess) { fprintf(stderr, "kernel_launch: device query failed\n"); grid = -1; return; }
        if (hipFuncSetAttribute((const void*)fwd_kernel, hipFuncAttributeMaxDynamicSharedMemorySize, LDS_BYTES) != hipSuccess) { fprintf(stderr, "kernel_launch: hipFuncSetAttribute failed\n"); grid = -1; return; }
        if (hipOccupancyMaxActiveBlocksPerMultiprocessor(&per_cu, (const void*)fwd_kernel, NTHR, LDS_BYTES) != hipSuccess || per_cu < 1) { fprintf(stderr, "kernel_launch: occupancy query says %d blocks/CU\n", per_cu); (void)hipGetLastError(); }
        grid = cus;
    }
    if (grid < 0) return;
    if (hipMemsetAsync((unsigned char*)d_ws + WS_BAR, 0, 16384, stream) != hipSuccess) { fprintf(stderr, "kernel_launch: memset of the barrier words failed\n"); return; }
    Params p{};
    for (int i = 0; i < N_IN; ++i) p.in[i] = (const float*)d_in[i];
    p.out = (float*)d_out; p.ws = (unsigned char*)d_ws; p.ph_lo = 0; p.ph_hi = N_PHASES;
    void* args[] = {&p};
    const hipError_t e = hipLaunchCooperativeKernel((const void*)fwd_kernel, dim3(grid), dim3(NTHR), args, LDS_BYTES, stream);
    if (e != hipSuccess) fprintf(stderr, "kernel_launch: cooperative launch failed: %s (grid %d)\n", hipGetErrorString(e), grid);
}
```

```cpp
#define REP_MASK 0u
#define EXTRA_SYNCS 0
#include <hip/hip_runtime.h>
#include <hip/hip_cooperative_groups.h>
#include <cstdio>
#include <cstdint>
namespace cg = cooperative_groups;
namespace pg8 {
#define PG8_LAS __attribute__((address_space(3)))
typedef unsigned short bf16_t;
typedef short bf16x8 __attribute__((ext_vector_type(8)));
typedef float f32x4 __attribute__((ext_vector_type(4)));
typedef unsigned u32x4 __attribute__((ext_vector_type(4)));
constexpr int BM = 256, BK = 64, HALF = 128, HTB = HALF * BK * 2  , STAGE_BYTES = 8 * HTB, NXCD = 8, WGM = 4;

__host__ __device__ __forceinline__ int lds_byte(int r, int c) { const int st = (r >> 4) * 2 + (c >> 5), rr = r & 15, cc = c & 31, ob = rr * 64 + cc * 2; return st * 1024 + (ob ^ (((ob >> 9) & 1) << 5)); }
__host__ __device__ __forceinline__ void stage_rc(int b, int& R, int& C) { const int st = b / 1024, sb = b % 1024, swz = sb ^ (((sb >> 9) & 1) << 5); R = (st >> 1) * 16 + swz / 64; C = (st & 1) * 32 + (swz % 64) / 2; }
__host__ __device__ __forceinline__ int perm32(int rho) { const int n = rho >> 4, i = rho & 15; return 8 * (i >> 2) + 4 * n + (i & 3); }

struct Unit { int pm, pn, kt0, nkt, part, tidx; };
struct Gemm { const bf16_t* A; const bf16_t* Bt; int M, N, K; };

struct StaticOrder {
    int nM, nN, nwg, G, c;
    __host__ __device__ void init(int M, int N, int G_, int c_) { nM = M / BM; nN = N / BM; nwg = nM * nN; G = G_; c = c_; }
    __host__ __device__ bool next(int i, Unit& u) const {
        const long L = (long)i * G + c; if (L >= nwg) return false;
        int wgid = (int)L; { const int q = nwg / NXCD, r = nwg % NXCD, xcd = wgid % NXCD, off = wgid / NXCD; wgid = (xcd < r ? xcd * (q + 1) : r * (q + 1) + (xcd - r) * q) + off; }
        const int nig = WGM * nN, gid = wgid / nig, fm = gid * WGM, gsz = (nM - fm) < WGM ? (nM - fm) : WGM;
        u.pm = fm + ((wgid % nig) % gsz); u.pn = (wgid % nig) / gsz; u.kt0 = 0; u.nkt = nkt; u.part = 0; u.tidx = 0; return true;
    }
    int nkt = 0;
    int split = 0;
    __host__ __device__ bool next_split(int i, Unit& u) const {
        const int full = nwg / G;
        if (!split || i < full) return next(i, u);
        if (i > full) return false;
        const int x = c & 7, j = c >> 3, cp = (j >> 2) * 8 + x, quarter = j & 3;
        StaticOrder t = *this; t.c = cp;
        if (!t.next(full, u)) return false;
        u.nkt = nkt >> 2; u.kt0 = quarter * u.nkt; u.part = quarter; u.tidx = cp; return true;
    }
    __device__ __forceinline__ void a_ready(const Unit&) const {}
    __device__ __forceinline__ void done(const Unit&) const {}
};
typedef float f32x2 __attribute__((ext_vector_type(2)));
__device__ __forceinline__ f32x2 gelu_pk(f32x2 v) {
    const f32x2 av = __builtin_elementwise_abs(v), d = av * 0.2316418882f + 1.0f;
    f32x2 t; t.x = __builtin_amdgcn_rcpf(d.x); t.y = __builtin_amdgcn_rcpf(d.y);
    f32x2 q = t * 0.5307027145f + (-0.7265760135f); q = q * t + 0.7107068705f; q = q * t + (-0.142248368f); q = q * t + 0.127414796f; q = q * t;
    const f32x2 s = (v * v) * (-0.72134752044f);
    f32x2 e; e.x = __builtin_amdgcn_exp2f(s.x); e.y = __builtin_amdgcn_exp2f(s.y);
    const f32x2 m = v * (q * e), r = v - m;
    f32x2 o; o.x = v.x < 0.f ? m.x : r.x; o.y = v.y < 0.f ? m.y : r.y; return o;
}

template <class Epi, class Sched, bool ALIGN_EPI = false, bool SP2 = false>
__device__ __forceinline__ void gemm_phase(PG8_LAS unsigned char* lds, const Gemm g, const Sched& S, const Epi& E) {
    int tid = threadIdx.x; asm volatile("" : "+v"(tid)); const int wid = __builtin_amdgcn_readfirstlane(tid >> 6), lane = tid & 63, wr = wid >> 2, wc = wid & 3, fr = lane & 15, fq = lane >> 4;
    const int K = g.K;
    unsigned voffA[2], voffB[2];
#pragma unroll
    for (int i = 0; i < 2; ++i) { int R, C; stage_rc(tid * 16 + i * 8192, R, C); const int Rb = Epi::PERM ? ((R & ~31) + perm32(R & 31)) : R;
        const int Ra = Epi::ROWPERM ? (128 * ((R >> 6) & 1) + 8 * (R & 15) + ((R >> 4) & 3)) : R; voffA[i] = (unsigned)(Ra * K + C) * 2u; voffB[i] = (unsigned)(Rb * K + C) * 2u; }
    const size_t kstep = (size_t)(BK * 2);
    const size_t hstep = (size_t)HALF * K * 2;
    const size_t tstep = 2 * hstep; const size_t hstepA = Epi::ROWPERM ? (size_t)4 * K * 2 : hstep;
    const unsigned ldsw = (unsigned)wid * 1024u;
    const int aoff = lds_byte(wr * 64 + fr, fq * 8), boff = lds_byte(wc * 32 + fr, fq * 8);
#define PG8_SA(b, h) (((b) * 2 + (h)) * HTB)
#define PG8_SB(b, h) ((4 + (b) * 2 + (h)) * HTB)
#define PG8_STAGE(bufoff, gbase, voff) do { _Pragma("unroll") for (int _i = 0; _i < 2; ++_i) \
        __builtin_amdgcn_global_load_lds((const unsigned*)((const char*)(gbase) + (voff)[_i]), (PG8_LAS unsigned*)(lds + (bufoff) + ldsw + _i * 8192), 16, 0, 0); } while (0)
#define PG8_LDA(dst, b, h) do { _Pragma("unroll") for (int m = 0; m < 4; ++m) _Pragma("unroll") for (int k = 0; k < 2; ++k) dst[m][k] = *(const PG8_LAS bf16x8*)(lds + PG8_SA(b, h) + aoff + m * 2048 + k * 1024); } while (0)
#define PG8_LDB(dst, b, h) do { _Pragma("unroll") for (int n = 0; n < 2; ++n) _Pragma("unroll") for (int k = 0; k < 2; ++k) dst[n][k] = *(const PG8_LAS bf16x8*)(lds + PG8_SB(b, h) + boff + n * 2048 + k * 1024); } while (0)
#define PG8_MMA(ai, bj, At, Bt) do { __builtin_amdgcn_s_setprio(1); _Pragma("unroll") for (int m = 0; m < 4; ++m) _Pragma("unroll") for (int n = 0; n < 2; ++n) _Pragma("unroll") for (int k = 0; k < 2; ++k) \
        acc[ai][bj][m][n] = __builtin_amdgcn_mfma_f32_16x16x32_bf16(Bt[n][k], At[m][k], acc[ai][bj][m][n], 0, 0, 0); __builtin_amdgcn_s_setprio(0); } while (0)
#define PG8_WAIT_V(n) asm volatile("s_waitcnt vmcnt(" #n ")" ::: "memory")
#define PG8_WAIT_L(n) asm volatile("s_waitcnt lgkmcnt(" #n ")" ::: "memory")
#define PG8_BAR __builtin_amdgcn_s_barrier()
#define PG8_SCHED __builtin_amdgcn_sched_barrier(0)
    Unit cur, nxt; int ui = 0;
    if (!S.next_split(0, cur)) return;
    f32x4 acc[2][2][4][2];
#pragma unroll
    for (int a = 0; a < 2; ++a)
#pragma unroll
        for (int b = 0; b < 2; ++b)
#pragma unroll
            for (int m = 0; m < 4; ++m)
#pragma unroll
                for (int n = 0; n < 2; ++n) acc[a][b][m][n] = (f32x4){0.f, 0.f, 0.f, 0.f};
    bf16x8 At[4][2], B0[2][2], B1[2][2];
    const char* cA = (const char*)g.A + (size_t)cur.pm * tstep + (size_t)cur.kt0 * kstep; const char* cB = (const char*)g.Bt + (size_t)cur.pn * tstep + (size_t)cur.kt0 * kstep;
    S.a_ready(cur);
    if constexpr (SP2) {
        PG8_STAGE(PG8_SB(0, 0), cB, voffB); PG8_STAGE(PG8_SB(0, 1), cB + hstep, voffB); PG8_STAGE(PG8_SA(0, 0), cA, voffA); PG8_STAGE(PG8_SA(0, 1), cA + hstepA, voffA);
        if (wr == 1) PG8_BAR;
        PG8_WAIT_V(2); PG8_BAR;
        PG8_STAGE(PG8_SB(1, 0), cB + kstep, voffB); PG8_STAGE(PG8_SA(1, 0), cA + kstep, voffA); PG8_STAGE(PG8_SB(1, 1), cB + hstep + kstep, voffB);
        PG8_WAIT_V(6); PG8_BAR;
    } else {
        PG8_STAGE(PG8_SB(0, 0), cB, voffB); PG8_STAGE(PG8_SA(0, 0), cA, voffA); PG8_STAGE(PG8_SB(0, 1), cB + hstep, voffB); PG8_STAGE(PG8_SA(0, 1), cA + hstepA, voffA);
        if (wr == 1) PG8_BAR;
        PG8_WAIT_V(4); PG8_BAR;
        PG8_STAGE(PG8_SB(1, 0), cB + kstep, voffB); PG8_STAGE(PG8_SA(1, 0), cA + kstep, voffA); PG8_STAGE(PG8_SB(1, 1), cB + hstep + kstep, voffB);
        PG8_WAIT_V(6); PG8_BAR;
    }
    for (;;) {
        const bool has_next = S.next_split(ui + 1, nxt); const int nt = cur.nkt;
        const char* nA = has_next ? (const char*)g.A + (size_t)nxt.pm * tstep + (size_t)nxt.kt0 * kstep : cA; const char* nB = has_next ? (const char*)g.Bt + (size_t)nxt.pn * tstep + (size_t)nxt.kt0 * kstep : cB;
        for (int t = 0; t < nt; t += 2) {
            const bool last = (t == nt - 2);
            const char* a1 = cA + (size_t)(t + 1) * kstep;
            const char* a2 = last ? nA : cA + (size_t)(t + 2) * kstep; const char* b2 = last ? nB : cB + (size_t)(t + 2) * kstep;
            const char* a3 = a2 + kstep; const char* b3 = b2 + kstep;
            if (last && has_next) S.a_ready(nxt);
            if constexpr (SP2) {
            PG8_LDB(B0, 0, 0); PG8_LDB(B1, 0, 1); PG8_SCHED; PG8_LDA(At, 0, 0); PG8_STAGE(PG8_SA(1, 1), a1 + hstepA, voffA);
            PG8_WAIT_V(8); PG8_WAIT_L(0); PG8_BAR; PG8_MMA(0, 0, At, B0); PG8_MMA(0, 1, At, B1); PG8_BAR; PG8_SCHED;
            PG8_LDA(At, 0, 1); PG8_STAGE(PG8_SB(0, 0), b2, voffB); PG8_STAGE(PG8_SB(0, 1), b2 + hstep, voffB); PG8_STAGE(PG8_SA(0, 0), a2, voffA);
            PG8_WAIT_V(8); PG8_WAIT_L(0); PG8_BAR; PG8_MMA(1, 0, At, B0); PG8_MMA(1, 1, At, B1); PG8_BAR; PG8_SCHED;
            PG8_LDB(B0, 1, 0); PG8_LDB(B1, 1, 1); PG8_SCHED; PG8_LDA(At, 1, 0); PG8_STAGE(PG8_SA(0, 1), a2 + hstepA, voffA);
            PG8_WAIT_V(8); PG8_WAIT_L(0); PG8_BAR; PG8_MMA(0, 0, At, B0); PG8_MMA(0, 1, At, B1); PG8_BAR; PG8_SCHED;
            PG8_LDA(At, 1, 1); PG8_STAGE(PG8_SB(1, 0), b3, voffB); PG8_STAGE(PG8_SB(1, 1), b3 + hstep, voffB); PG8_STAGE(PG8_SA(1, 0), a3, voffA);
            PG8_WAIT_V(8); PG8_WAIT_L(0); PG8_BAR; PG8_MMA(1, 0, At, B0); PG8_MMA(1, 1, At, B1); PG8_BAR; PG8_SCHED;
            } else {
            PG8_LDB(B0, 0, 0); PG8_SCHED; PG8_LDA(At, 0, 0); PG8_STAGE(PG8_SA(1, 1), a1 + hstepA, voffA);
            PG8_WAIT_L(8); PG8_BAR; PG8_WAIT_L(0); PG8_MMA(0, 0, At, B0); PG8_BAR; PG8_SCHED;
            PG8_LDB(B1, 0, 1); PG8_STAGE(PG8_SB(0, 0), b2, voffB);
            PG8_BAR; PG8_WAIT_L(0); PG8_MMA(0, 1, At, B1); PG8_BAR;
            PG8_LDA(At, 0, 1); PG8_STAGE(PG8_SA(0, 0), a2, voffA);
            PG8_BAR; PG8_WAIT_L(0); PG8_MMA(1, 0, At, B0); PG8_BAR; PG8_SCHED;
            PG8_STAGE(PG8_SB(0, 1), b2 + hstep, voffB);
            PG8_WAIT_V(6); PG8_BAR; PG8_MMA(1, 1, At, B1); PG8_BAR;
            PG8_LDB(B0, 1, 0); PG8_SCHED; PG8_LDA(At, 1, 0); PG8_STAGE(PG8_SA(0, 1), a2 + hstepA, voffA);
            PG8_WAIT_L(8); PG8_BAR; PG8_WAIT_L(0); PG8_MMA(0, 0, At, B0); PG8_BAR; PG8_SCHED;
            PG8_LDB(B1, 1, 1); PG8_STAGE(PG8_SB(1, 0), b3, voffB);
            PG8_BAR; PG8_WAIT_L(0); PG8_MMA(0, 1, At, B1); PG8_BAR;
            PG8_LDA(At, 1, 1); PG8_STAGE(PG8_SA(1, 0), a3, voffA);
            PG8_BAR; PG8_WAIT_L(0); PG8_MMA(1, 0, At, B0); PG8_BAR; PG8_SCHED;
            PG8_STAGE(PG8_SB(1, 1), b3 + hstep, voffB);
            PG8_WAIT_V(6); PG8_BAR; PG8_MMA(1, 1, At, B1); PG8_BAR;
            }
        }
        if constexpr (ALIGN_EPI) { if (wr == 0) PG8_BAR; }
        if constexpr (!Epi::AFTER_DRAIN) { E(acc, cur, wr, wc, fr, fq); S.done(cur); }
        if (!has_next) break;
#pragma unroll
        for (int a = 0; a < 2; ++a)
#pragma unroll
            for (int b = 0; b < 2; ++b)
#pragma unroll
                for (int m = 0; m < 4; ++m)
#pragma unroll
                    for (int n = 0; n < 2; ++n) acc[a][b][m][n] = (f32x4){0.f, 0.f, 0.f, 0.f};
        cur = nxt; cA = nA; cB = nB; ++ui;
        if constexpr (ALIGN_EPI) { if (wr == 1) PG8_BAR; }
    }
    PG8_WAIT_V(0);
    if constexpr (!ALIGN_EPI) { if (wr == 0) PG8_BAR; }
    PG8_BAR;
    if constexpr (Epi::AFTER_DRAIN) { E.fused(acc, cur, wr, wc, fr, fq, lds, wid, lane); S.done(cur); }
#undef PG8_SA
#undef PG8_SB
#undef PG8_STAGE
#undef PG8_LDA
#undef PG8_LDB
#undef PG8_MMA
#undef PG8_WAIT_V
#undef PG8_WAIT_L
#undef PG8_BAR
#undef PG8_SCHED
}
}
using pg8::bf16_t; using pg8::bf16x8; using pg8::f32x4; using pg8::u32x4; using pg8::Unit;
typedef PG8_LAS unsigned char* LP;
typedef unsigned u32x2 __attribute__((ext_vector_type(2)));
typedef float f32x2 __attribute__((ext_vector_type(2)));
typedef float f32x16 __attribute__((ext_vector_type(16)));
typedef __bf16 bf16x2_t __attribute__((ext_vector_type(2)));
#define DI __device__ __forceinline__

constexpr int D = 2048, NB = 8, SEQ = 2048, CTXL = 256, NLAT = NB * SEQ, NCTX = NB * CTXL, MT = NLAT + NCTX;
constexpr int INW = 3072, DFF = 5632, NUP = 2 * DFF;
constexpr int NTHR = 512;
constexpr float EPS = 1e-6f;
constexpr float LOG2E = 1.4426950408889634f;
constexpr float QSCALE = 0.08838834764831845f * 1.4426950408889634f;
constexpr int LDS_BYTES = 131072 + 16;
enum { I_X = 0, I_C, I_CTX, I_CCTX, I_N1G, I_N2G, I_WADA, I_BADA, I_WIN, I_QNG, I_KNG, I_SINK, I_POOLW, I_POOLS, I_SGUNG, I_SGUW, I_SGUB, I_WOUT, I_WUP, I_CONVW, I_CONVB, I_WDOWN, I_FNG, N_IN };
constexpr size_t SZ_WIN = (size_t)INW * D * 2, SZ_WOUT = (size_t)D * D * 2, SZ_WUP = (size_t)NUP * D * 2, SZ_WDN = (size_t)D * DFF * 2;
constexpr size_t WS_WIN = 0, WS_WOUT = WS_WIN + 2 * SZ_WIN, WS_WUP = WS_WOUT + 2 * SZ_WOUT, WS_WDN = WS_WUP + 2 * SZ_WUP;
constexpr size_t WS_BAR = WS_WDN + 2 * SZ_WDN;
constexpr size_t WS_MOD = WS_BAR + 16384;
constexpr size_t WS_ROPE = WS_MOD + (size_t)2 * 9 * 6 * D * 4;
constexpr size_t WS_H = WS_ROPE + 64 * 32 * 2 * 4;
constexpr size_t WS_X = WS_H + (size_t)MT * D * 2;
constexpr size_t WS_HB = WS_X + (size_t)MT * D * 4;
constexpr size_t WS_R1 = WS_HB + (size_t)144 * 4 * NUP * 4;
constexpr size_t WS_P = WS_R1;
constexpr size_t WS_MIX = WS_P + (size_t)MT * INW * 2;
constexpr size_t WS_VTL = WS_MIX + (size_t)MT * D * 2;
constexpr size_t WS_VTC = WS_VTL + (size_t)NB * 2 * 128 * SEQ * 2;
constexpr size_t WS_R1_END_A = WS_VTC + (size_t)NB * 2 * 128 * CTXL * 2;
constexpr size_t WS_ACT = WS_R1;
constexpr size_t WS_R1_END_B = WS_ACT + (size_t)MT * DFF * 2;
constexpr size_t WS_XP = WS_R1_END_A > WS_R1_END_B ? WS_R1_END_A : WS_R1_END_B;
constexpr size_t WS_KVP = WS_XP + (size_t)64 * 3 * 65536 * 4;
constexpr size_t WS_SSQ = WS_KVP + (size_t)4 * NCTX * 512 * 4;
constexpr size_t WS_END = WS_SSQ + (size_t)MT * 4;

struct Params { const float* in[N_IN]; float* out; unsigned char* ws; int ph_lo, ph_hi; };
typedef const __attribute__((address_space(4))) Params* CP;

DI int tid_l() { int t = threadIdx.x; asm volatile("" : "+v"(t)); return t; }
DI int bid_l() { int b = blockIdx.x; asm volatile("" : "+s"(b)); return b; }
DI unsigned pk2(float a, float b) { f32x2 v = {a, b}; bf16x2_t r = __builtin_convertvector(v, bf16x2_t); return __builtin_bit_cast(unsigned, r); }
DI float bf_lo(unsigned w) { return __uint_as_float(w << 16); }
DI float bf_hi(unsigned w) { return __uint_as_float(w & 0xffff0000u); }
DI float silu_f(float x) { return x * __builtin_amdgcn_rcpf(1.0f + __builtin_amdgcn_exp2f(-x * LOG2E)); }
DI float gelu_f(float x) { f32x2 v = {x, x}; return pg8::gelu_pk(v).x; }
DI f32x4 gelu4(f32x4 x) { f32x2 a = pg8::gelu_pk((f32x2){x[0], x[1]}), b = pg8::gelu_pk((f32x2){x[2], x[3]}); return (f32x4){a.x, a.y, b.x, b.y}; }

struct EpiP {
    static constexpr bool PERM = true, AFTER_DRAIN = false, ROWPERM = false;
    float* ssq;
    bf16_t* O; int ldc, row_off, col_off, gelu_from_pn;
    DI void operator()(const f32x4 (&acc)[2][2][4][2], const Unit& u, int wr, int wc, int fr, int fq) const {
        const int row0 = row_off + u.pm * 256 + wr * 64 + fr, col0 = col_off + u.pn * 256 + wc * 32 + 8 * fq;
        const bool gsq = (u.pn >= 10) && (gelu_from_pn < 12);
#pragma unroll
        for (int ai = 0; ai < 2; ++ai)
#pragma unroll
            for (int m = 0; m < 4; ++m) { bf16_t* rowp = O + (size_t)(row0 + ai * 128 + m * 16) * ldc + col0; float s = 0.f;
#pragma unroll
                for (int bj = 0; bj < 2; ++bj) { f32x4 v0 = acc[ai][bj][m][0], v1 = acc[ai][bj][m][1];
                    if (u.pn >= gelu_from_pn) { v0 = gelu4(v0); v1 = gelu4(v1); }
                    s += v0[0] * v0[0] + v0[1] * v0[1] + v0[2] * v0[2] + v0[3] * v0[3] + v1[0] * v1[0] + v1[1] * v1[1] + v1[2] * v1[2] + v1[3] * v1[3];
                    u32x4 w; w.x = pk2(v0[0], v0[1]); w.y = pk2(v0[2], v0[3]); w.z = pk2(v1[0], v1[1]); w.w = pk2(v1[2], v1[3]);
                    *(u32x4*)(rowp + bj * 128) = w; }
                if (gsq) { s += __shfl_xor(s, 16); s += __shfl_xor(s, 32); if (fq == 0) atomicAdd(ssq + row0 + ai * 128 + m * 16, s); } }
    }
};
struct EpiKVPart {
    static constexpr bool PERM = false, AFTER_DRAIN = false, ROWPERM = false;
    float* kvp;
    DI void operator()(const f32x4 (&acc)[2][2][4][2], const Unit& u, int wr, int wc, int fr, int fq) const {
        float* op = kvp + ((size_t)u.part * NCTX + u.pm * 256 + wr * 64 + fr) * 512 + u.pn * 256 + wc * 32 + 4 * fq;
#pragma unroll
        for (int ai = 0; ai < 2; ++ai)
#pragma unroll
            for (int m = 0; m < 4; ++m)
#pragma unroll
                for (int bj = 0; bj < 2; ++bj)
#pragma unroll
                    for (int n = 0; n < 2; ++n) *(f32x4*)(op + (size_t)(ai * 128 + m * 16) * 512 + bj * 128 + n * 16) = acc[ai][bj][m][n];
    }
};
struct EpiRes {
    static constexpr bool PERM = false, AFTER_DRAIN = false, ROWPERM = false;
    const float* base_lat; const float* base_ctx; float* out; float* xpart; const float* gate;
    DI void operator()(const f32x4 (&acc)[2][2][4][2], const Unit& u, int wr, int wc, int fr, int fq) const {
        const int row0 = u.pm * 256 + wr * 64 + fr, col0 = u.pn * 256 + wc * 32 + 4 * fq;
        const int b = u.pm < 64 ? (u.pm >> 3) : 8;
        const float* gp = gate + (size_t)b * 6 * D + col0;
        f32x4 gv[2][2];
#pragma unroll
        for (int bj = 0; bj < 2; ++bj)
#pragma unroll
            for (int n = 0; n < 2; ++n) gv[bj][n] = *(const f32x4*)(gp + bj * 128 + n * 16);
        if (u.part != 0) {
            float* xp = xpart + ((size_t)(u.tidx * 3 + u.part - 1) << 16) + (size_t)(wr * 64 + fr) * 256 + wc * 32 + 4 * fq;
#pragma unroll
            for (int ai = 0; ai < 2; ++ai)
#pragma unroll
                for (int m = 0; m < 4; ++m)
#pragma unroll
                    for (int bj = 0; bj < 2; ++bj)
#pragma unroll
                        for (int n = 0; n < 2; ++n) *(f32x4*)(xp + (size_t)(ai * 128 + m * 16) * 256 + bj * 128 + n * 16) = gv[bj][n] * acc[ai][bj][m][n];
            return;
        }
        const float* bp = (u.pm < 64 ? base_lat + (size_t)row0 * D : base_ctx + (size_t)(row0 - NLAT) * D) + col0;
        float* op = out + (size_t)row0 * D + col0;
        f32x4 bs[4], bn[4];
#pragma unroll
        for (int q = 0; q < 4; ++q) bs[q] = *(const f32x4*)(bp + (q >> 1) * 128 + (q & 1) * 16);
#pragma unroll
        for (int g = 0; g < 8; ++g) { const int ai = g >> 2, m = g & 3; const size_t off = (size_t)(ai * 128 + m * 16) * D;
            if (g < 7) { const size_t offn = (size_t)(((g + 1) >> 2) * 128 + ((g + 1) & 3) * 16) * D;
#pragma unroll
                for (int q = 0; q < 4; ++q) bn[q] = *(const f32x4*)(bp + offn + (q >> 1) * 128 + (q & 1) * 16); }
#pragma unroll
            for (int q = 0; q < 4; ++q) { const int bj = q >> 1, n = q & 1; *(f32x4*)(op + off + bj * 128 + n * 16) = bs[q] + gv[bj][n] * acc[ai][bj][m][n]; }
            asm volatile("" ::: "memory");
#pragma unroll
            for (int q = 0; q < 4; ++q) bs[q] = bn[q]; }
    }
};
struct EpiConvGlu {
    static constexpr bool PERM = true, AFTER_DRAIN = false, ROWPERM = true;
    bf16_t* act; float* hb; const float* cw; const float* cb;
    DI void operator()(const f32x4 (&acc)[2][2][4][2], const Unit& u, int wr, int wc, int fr, int fq) const {
        const int tok0 = u.pm * 256 + 128 * wr + 8 * fr, cl0 = wc * 32 + 8 * fq;
#pragma unroll
        for (int n = 0; n < 2; ++n) {
            const int cl = cl0 + 4 * n, chg = u.pn * 128 + cl, chv = DFF + chg;
            const f32x4 w0g = *(const f32x4*)(cw + chg), w1g = *(const f32x4*)(cw + NUP + chg), w2g = *(const f32x4*)(cw + 2 * NUP + chg), bg = *(const f32x4*)(cb + chg);
            const f32x4 w0v = *(const f32x4*)(cw + chv), w1v = *(const f32x4*)(cw + NUP + chv), w2v = *(const f32x4*)(cw + 2 * NUP + chv), bv = *(const f32x4*)(cb + chv);
            f32x4 gp, gn, vp, vn;
#pragma unroll
            for (int e = 0; e < 4; ++e) {
                gp[e] = __int_as_float(__builtin_amdgcn_update_dpp(0, __float_as_int(acc[1][0][3][n][e]), 0x111, 0xf, 0xf, true)); gn[e] = __int_as_float(__builtin_amdgcn_update_dpp(0, __float_as_int(acc[0][0][0][n][e]), 0x101, 0xf, 0xf, true));
                vp[e] = __int_as_float(__builtin_amdgcn_update_dpp(0, __float_as_int(acc[1][1][3][n][e]), 0x111, 0xf, 0xf, true)); vn[e] = __int_as_float(__builtin_amdgcn_update_dpp(0, __float_as_int(acc[0][1][0][n][e]), 0x101, 0xf, 0xf, true)); }
            if (fr == 0) { gp = (f32x4){0.f, 0.f, 0.f, 0.f}; vp = gp; }
            if (fr == 15) { gn = (f32x4){0.f, 0.f, 0.f, 0.f}; vn = gn; }
            if (fr == 0 || fr == 15) {
                float* hp = hb + ((size_t)(u.pm * 2 + wr) * 4 + (fr ? 2 : 0)) * NUP + u.pn * 256 + cl;
                const int j0 = fr ? 6 : 0;
                const f32x4 g0 = fr ? acc[1][0][2][n] : acc[0][0][0][n], g1 = fr ? acc[1][0][3][n] : acc[0][0][1][n];
                const f32x4 v0 = fr ? acc[1][1][2][n] : acc[0][1][0][n], v1 = fr ? acc[1][1][3][n] : acc[0][1][1][n];
                (void)j0;
                *(f32x4*)(hp) = g0; *(f32x4*)(hp + 128) = v0; *(f32x4*)(hp + NUP) = g1; *(f32x4*)(hp + NUP + 128) = v1;
            }
#pragma unroll
            for (int j = 0; j < 8; ++j) {
                const f32x4 gP = j ? acc[(j - 1) >> 2][0][(j - 1) & 3][n] : gp, gC = acc[j >> 2][0][j & 3][n], gN = j < 7 ? acc[(j + 1) >> 2][0][(j + 1) & 3][n] : gn;
                const f32x4 vP = j ? acc[(j - 1) >> 2][1][(j - 1) & 3][n] : vp, vC = acc[j >> 2][1][j & 3][n], vN = j < 7 ? acc[(j + 1) >> 2][1][(j + 1) & 3][n] : vn;
                const f32x4 cg_ = bg + w0g * gP + w1g * gC + w2g * gN, cv_ = bv + w0v * vP + w1v * vC + w2v * vN;
                f32x4 o;
#pragma unroll
                for (int e = 0; e < 4; ++e) o[e] = silu_f(cg_[e]) * cv_[e];
                u32x2 w; w.x = pk2(o[0], o[1]); w.y = pk2(o[2], o[3]);
                *(u32x2*)(act + (size_t)(tok0 + j) * DFF + u.pn * 128 + cl) = w;
            }
            asm volatile("" ::: "memory");
        }
    }
};
#include <cstdlib>
#include <vector>

#define XB_TMO      128
#define XB_XCNT(j)  (256  + 64 * (j))
#define XB_XSUB(j)  (1280 + 64 * (j))
#define XB_XGEN(j)  (2304 + 64 * (j))
#define XB_TOP      3328
#define XB_TOPGEN   3392
#define XCD_BAR_WORDS 3456
#define XB_SPIN_CAP (1u << 18)

__device__ __forceinline__ unsigned xb_ld(unsigned* p)              { return __hip_atomic_load(p, __ATOMIC_RELAXED, __HIP_MEMORY_SCOPE_AGENT); }
__device__ __forceinline__ unsigned xb_add(unsigned* p, unsigned v) { return __hip_atomic_fetch_add(p, v, __ATOMIC_RELAXED, __HIP_MEMORY_SCOPE_AGENT); }
__device__ __forceinline__ unsigned xb_xcc_id() { return (unsigned)__builtin_amdgcn_s_getreg((3 << 11) | 20) & 0xFu; }
#define XB_SPIN(cond, bar) do { unsigned _sp = 0; while (cond) { __builtin_amdgcn_s_sleep(1); \
    if ((++_sp & 255u) == 0u) { if (xb_ld(&(bar)[XB_TMO])) break; if (_sp > XB_SPIN_CAP) { atomicAdd(&(bar)[XB_TMO], 1u); break; } } } } while (0)

struct XcdBarrier {
    unsigned* bar; unsigned x;
    volatile PG8_LAS unsigned* st;
};

__device__ __forceinline__ XcdBarrier xcd_barrier_post(unsigned* bar, volatile PG8_LAS unsigned* st) {
    XcdBarrier b; b.bar = bar; b.x = xb_xcc_id(); b.st = st;
    if (threadIdx.x == 0) (void)xb_add(&bar[XB_XCNT(b.x)], 1u);
    return b;
}
__device__ __forceinline__ void xcd_barrier_complete(unsigned* bar, unsigned x, unsigned& nloc, unsigned& nx) {
    const unsigned G = gridDim.x * gridDim.y * gridDim.z;
    unsigned sum, cnt, mine, sp = 0u;
    for (;;) {
        sum = 0u; cnt = 0u; mine = 0u;
#pragma unroll
        for (unsigned j = 0; j < 16; ++j) { const unsigned c = xb_ld(&bar[XB_XCNT(j)]); sum += c; cnt += (c > 0u) ? 1u : 0u; mine = (j == x) ? c : mine; }
        if (sum == G) break;
        __builtin_amdgcn_s_sleep(1);
        if ((++sp & 255u) == 0u) { if (xb_ld(&bar[XB_TMO])) break; if (sp > XB_SPIN_CAP) { atomicAdd(&bar[XB_TMO], 1u); break; } }
    }
    nloc = mine > 0u ? mine : 1u; nx = cnt > 0u ? cnt : 1u;
}

__device__ __forceinline__ void xcd_barrier(const XcdBarrier& b) {
    asm volatile("s_waitcnt vmcnt(0)" ::: "memory");
    __syncthreads();
    if (threadIdx.x == 0) {
        unsigned* bar = b.bar;
        __builtin_amdgcn_s_waitcnt(0);
        unsigned nloc = b.st[0], nx = b.st[1];
        if (nloc == 0u) { xcd_barrier_complete(bar, b.x, nloc, nx); b.st[0] = nloc; b.st[1] = nx; }
        const unsigned old = xb_add(&bar[XB_XSUB(b.x)], 1u);
        const unsigned gen = old / nloc;
        if (old + 1u == (gen + 1u) * nloc) {
            __builtin_amdgcn_fence(__ATOMIC_RELEASE, "agent");
            asm volatile("s_waitcnt vmcnt(0)" ::: "memory");
            const unsigned og = xb_add(&bar[XB_TOP], 1u);
            const unsigned tg = og / nx;
            if (og + 1u == (tg + 1u) * nx) xb_add(&bar[XB_TOPGEN], 1u);
            else XB_SPIN(xb_ld(&bar[XB_TOPGEN]) == tg, bar);
            __builtin_amdgcn_fence(__ATOMIC_ACQUIRE, "agent");
            xb_add(&bar[XB_XGEN(b.x)], 1u);
            asm volatile("s_waitcnt vmcnt(0)" ::: "memory");
        } else {
            XB_SPIN(xb_ld(&bar[XB_XGEN(b.x)]) == gen, bar);
            __builtin_amdgcn_fence(__ATOMIC_ACQUIRE, "agent");
            asm volatile("s_waitcnt vmcnt(0)" ::: "memory");
        }
    }
    __syncthreads();
}
DI void conv_tile(const float* __restrict__ W, int N, int k0, int srcc0, bf16_t* __restrict__ Wt, int K, int dstn0, LP lds, int tid) {
    PG8_LAS float* tile = (PG8_LAS float*)lds;
#pragma unroll
    for (int i = 0; i < 4; ++i) { const int k = (tid >> 4) + 32 * i, n4 = (tid & 15) * 4;
        const f32x4 v = *(const f32x4*)(W + (size_t)(k0 + k) * N + srcc0 + n4);
        tile[k * 65 + n4 + 0] = v[0]; tile[k * 65 + n4 + 1] = v[1]; tile[k * 65 + n4 + 2] = v[2]; tile[k * 65 + n4 + 3] = v[3]; }
    __syncthreads();
    const int n = tid >> 3, ks = (tid & 7) * 16;
    u32x4 o0, o1;
    o0.x = pk2(tile[(ks + 0) * 65 + n], tile[(ks + 1) * 65 + n]); o0.y = pk2(tile[(ks + 2) * 65 + n], tile[(ks + 3) * 65 + n]);
    o0.z = pk2(tile[(ks + 4) * 65 + n], tile[(ks + 5) * 65 + n]); o0.w = pk2(tile[(ks + 6) * 65 + n], tile[(ks + 7) * 65 + n]);
    o1.x = pk2(tile[(ks + 8) * 65 + n], tile[(ks + 9) * 65 + n]); o1.y = pk2(tile[(ks + 10) * 65 + n], tile[(ks + 11) * 65 + n]);
    o1.z = pk2(tile[(ks + 12) * 65 + n], tile[(ks + 13) * 65 + n]); o1.w = pk2(tile[(ks + 14) * 65 + n], tile[(ks + 15) * 65 + n]);
    bf16_t* dp = Wt + (size_t)(dstn0 + n) * K + k0 + ks;
    *(u32x4*)dp = o0; *(u32x4*)(dp + 8) = o1;
    __syncthreads();
}
DI void adaln_item(CP P, int item, LP lds) {
    const int tid = tid_l(); unsigned char* ws = P->ws;
    const int l = item / 96, n0 = (item % 96) * 128;
    PG8_LAS float* s = (PG8_LAS float*)lds;
    { float cv_[36];
#pragma unroll
      for (int q = 0; q < 36; ++q) { const int i = tid + q * NTHR, b = i >> 11, k = i & 2047; cv_[q] = b < 8 ? P->in[I_C][b * D + k] : P->in[I_CCTX][k]; }
#pragma unroll
      for (int q = 0; q < 36; ++q) s[tid + q * NTHR] = silu_f(cv_[q]); }
    __syncthreads();
    const int kg = tid >> 5, cq = tid & 31;
    float acc[9][4];
#pragma unroll
    for (int b = 0; b < 9; ++b)
#pragma unroll
        for (int e = 0; e < 4; ++e) acc[b][e] = 0.f;
    const float* W = P->in[I_WADA] + (size_t)l * D * 6 * D + n0 + 4 * cq;
#pragma unroll 8
    for (int kk = 0; kk < 128; ++kk) { const int k = kg * 128 + kk; const f32x4 w = __builtin_nontemporal_load((const f32x4*)(W + (size_t)k * 6 * D));
#pragma unroll
        for (int b = 0; b < 9; ++b) { const float sv = s[b * D + k];
#pragma unroll
            for (int e = 0; e < 4; ++e) acc[b][e] += sv * w[e]; } }
    __syncthreads();
    PG8_LAS float* red = (PG8_LAS float*)lds;
#pragma unroll
    for (int b = 0; b < 9; ++b)
#pragma unroll
        for (int e = 0; e < 4; ++e) red[(kg * 9 + b) * 128 + 4 * cq + e] = acc[b][e];
    __syncthreads();
    float* mod = (float*)(ws + WS_MOD);
    for (int o = tid; o < 9 * 128; o += NTHR) { const int b = o >> 7, ci = o & 127; float sum = P->in[I_BADA][l * 6 * D + n0 + ci];
        for (int g = 0; g < 16; ++g) sum += red[(g * 9 + b) * 128 + ci];
        mod[((size_t)l * 9 + b) * 6 * D + n0 + ci] = sum; }
    __syncthreads();
}
struct TileDesc { const float* src; bf16_t* dst; int srcN, dstK; };
DI TileDesc tile_desc(CP P, int T) {
    unsigned char* ws = P->ws; TileDesc d;
    const int l = T / 5504; int t = T % 5504;
    if (t < 768) { const int kt = t / 48, nt = t % 48; d.srcN = INW; d.dstK = D; d.src = P->in[I_WIN] + (size_t)l * D * INW + (size_t)(kt * 128) * INW + nt * 64; d.dst = (bf16_t*)(ws + WS_WIN + l * SZ_WIN) + (size_t)(nt * 64) * D + kt * 128; return d; }
    t -= 768;
    if (t < 512) { const int kt = t / 32, nt = t % 32; d.srcN = D; d.dstK = D; d.src = P->in[I_WOUT] + (size_t)l * D * D + (size_t)(kt * 128) * D + nt * 64; d.dst = (bf16_t*)(ws + WS_WOUT + l * SZ_WOUT) + (size_t)(nt * 64) * D + kt * 128; return d; }
    t -= 512;
    if (t < 2816) { const int kt = t / 176, nt = t % 176; const int np = nt * 64, pn = np >> 8, rem = np & 255; const int srcc = rem < 128 ? 128 * pn + rem : DFF + 128 * pn + rem - 128;
        d.srcN = NUP; d.dstK = D; d.src = P->in[I_WUP] + (size_t)l * D * NUP + (size_t)(kt * 128) * NUP + srcc; d.dst = (bf16_t*)(ws + WS_WUP + l * SZ_WUP) + (size_t)np * D + kt * 128; return d; }
    t -= 2816;
    { const int kt = t / 32, nt = t % 32; d.srcN = D; d.dstK = DFF; d.src = P->in[I_WDOWN] + (size_t)l * DFF * D + (size_t)(kt * 128) * D + nt * 64; d.dst = (bf16_t*)(ws + WS_WDN + l * SZ_WDN) + (size_t)(nt * 64) * DFF + kt * 128; return d; }
}
constexpr int FILL_PER = 12, FILL_TILES = 2 * 160 * FILL_PER;
DI int prep_tile_index(int bid, int G, int k) {
    if (G != 256) { const int T = bid + G * k; return T < 11008 ? T : -1; }
    if (bid >= 192) { if (k < 10) return (bid - 192) + 64 * k; k -= 10; }
    const int T = 640 + bid + 256 * k; return T < 5248 ? T : -1;
}
DI void convert_tiles_lin(CP P, LP lds, int Tbase, int stride, int count) {
    const int tid = tid_l();
    PG8_LAS float* tile = (PG8_LAS float*)lds;
    const int lk = tid >> 4, ln4 = (tid & 15) * 4, on = tid >> 3, oks = (tid & 7) * 16;
    f32x4 c0[4], c1[4]; TileDesc d0, d1;
    if (count > 0) { d0 = tile_desc(P, Tbase);
#pragma unroll
        for (int i = 0; i < 4; ++i) c0[i] = *(const f32x4*)(d0.src + (size_t)(lk + 32 * i) * d0.srcN + ln4); }
    if (count > 1) { d1 = tile_desc(P, Tbase + stride);
#pragma unroll
        for (int i = 0; i < 4; ++i) c1[i] = *(const f32x4*)(d1.src + (size_t)(lk + 32 * i) * d1.srcN + ln4); }
    for (int k = 0; k < count; ++k) {
        f32x4 c2[4]; TileDesc d2;
        if (k + 2 < count) { d2 = tile_desc(P, Tbase + (k + 2) * stride);
#pragma unroll
            for (int i = 0; i < 4; ++i) c2[i] = *(const f32x4*)(d2.src + (size_t)(lk + 32 * i) * d2.srcN + ln4); }
#pragma unroll
        for (int i = 0; i < 4; ++i) { const int kk = lk + 32 * i; tile[kk * 65 + ln4 + 0] = c0[i][0]; tile[kk * 65 + ln4 + 1] = c0[i][1]; tile[kk * 65 + ln4 + 2] = c0[i][2]; tile[kk * 65 + ln4 + 3] = c0[i][3]; }
        __syncthreads();
        u32x4 o0, o1;
        o0.x = pk2(tile[(oks + 0) * 65 + on], tile[(oks + 1) * 65 + on]); o0.y = pk2(tile[(oks + 2) * 65 + on], tile[(oks + 3) * 65 + on]);
        o0.z = pk2(tile[(oks + 4) * 65 + on], tile[(oks + 5) * 65 + on]); o0.w = pk2(tile[(oks + 6) * 65 + on], tile[(oks + 7) * 65 + on]);
        o1.x = pk2(tile[(oks + 8) * 65 + on], tile[(oks + 9) * 65 + on]); o1.y = pk2(tile[(oks + 10) * 65 + on], tile[(oks + 11) * 65 + on]);
        o1.z = pk2(tile[(oks + 12) * 65 + on], tile[(oks + 13) * 65 + on]); o1.w = pk2(tile[(oks + 14) * 65 + on], tile[(oks + 15) * 65 + on]);
        bf16_t* dp = d0.dst + (size_t)on * d0.dstK + oks;
        __builtin_nontemporal_store(o0, (u32x4*)dp); __builtin_nontemporal_store(o1, (u32x4*)(dp + 8));
        __syncthreads();
        d0 = d1; d1 = d2;
#pragma unroll
        for (int i = 0; i < 4; ++i) { c0[i] = c1[i]; c1[i] = c2[i]; }
    }
}
DI void filler_phase(CP P, int slot, LP lds) {
    const int bid = bid_l();
    if (gridDim.x != 256) return;
    if (slot < 2) { if (bid >= 96) convert_tiles_lin(P, lds, 6016 + slot * 1920 + (bid - 96), 160, 12); }
    else if (slot == 2) { if (bid >= 64) convert_tiles_lin(P, lds, 5248 + (bid - 64), 192, 4); }
    else { if (bid >= 64) convert_tiles_lin(P, lds, 9856 + (bid - 64), 192, 6); }
}
DI void prep_phase(CP P, LP lds) {
    const int tid = tid_l(), bid = bid_l(), G = gridDim.x;
    for (int item = bid; item < 192; item += G) adaln_item(P, item, lds);
    if (bid == G - 1) { float* tab = (float*)(P->ws + WS_ROPE);
        for (int i = tid; i < 64 * 32; i += NTHR) { const int pos = i >> 5, f = i & 31; const float inv = 1.0f / powf(10000.0f, (float)(2 * f) / 64.0f); const float ang = (float)pos * inv;
            tab[2 * i] = cosf(ang); tab[2 * i + 1] = sinf(ang); } }
    PG8_LAS float* tile = (PG8_LAS float*)lds;
    const int lk = tid >> 4, ln4 = (tid & 15) * 4, on = tid >> 3, oks = (tid & 7) * 16;
    int T0 = prep_tile_index(bid, G, 0), T1 = T0 >= 0 ? prep_tile_index(bid, G, 1) : -1;
    f32x4 c0[4], c1[4]; TileDesc d0, d1;
    if (T0 >= 0) { d0 = tile_desc(P, T0);
#pragma unroll
        for (int i = 0; i < 4; ++i) c0[i] = *(const f32x4*)(d0.src + (size_t)(lk + 32 * i) * d0.srcN + ln4); }
    if (T1 >= 0) { d1 = tile_desc(P, T1);
#pragma unroll
        for (int i = 0; i < 4; ++i) c1[i] = *(const f32x4*)(d1.src + (size_t)(lk + 32 * i) * d1.srcN + ln4); }
    for (int k = 0; T0 >= 0; ++k) {
        const int T2 = T1 >= 0 ? prep_tile_index(bid, G, k + 2) : -1;
        f32x4 c2[4]; TileDesc d2;
        if (T2 >= 0) { d2 = tile_desc(P, T2);
#pragma unroll
            for (int i = 0; i < 4; ++i) c2[i] = *(const f32x4*)(d2.src + (size_t)(lk + 32 * i) * d2.srcN + ln4); }
#pragma unroll
        for (int i = 0; i < 4; ++i) { const int kk = lk + 32 * i; tile[kk * 65 + ln4 + 0] = c0[i][0]; tile[kk * 65 + ln4 + 1] = c0[i][1]; tile[kk * 65 + ln4 + 2] = c0[i][2]; tile[kk * 65 + ln4 + 3] = c0[i][3]; }
        __syncthreads();
        u32x4 o0, o1;
        o0.x = pk2(tile[(oks + 0) * 65 + on], tile[(oks + 1) * 65 + on]); o0.y = pk2(tile[(oks + 2) * 65 + on], tile[(oks + 3) * 65 + on]);
        o0.z = pk2(tile[(oks + 4) * 65 + on], tile[(oks + 5) * 65 + on]); o0.w = pk2(tile[(oks + 6) * 65 + on], tile[(oks + 7) * 65 + on]);
        o1.x = pk2(tile[(oks + 8) * 65 + on], tile[(oks + 9) * 65 + on]); o1.y = pk2(tile[(oks + 10) * 65 + on], tile[(oks + 11) * 65 + on]);
        o1.z = pk2(tile[(oks + 12) * 65 + on], tile[(oks + 13) * 65 + on]); o1.w = pk2(tile[(oks + 14) * 65 + on], tile[(oks + 15) * 65 + on]);
        bf16_t* dp = d0.dst + (size_t)on * d0.dstK + oks;
        *(u32x4*)dp = o0; *(u32x4*)(dp + 8) = o1;
        __syncthreads();
        T0 = T1; T1 = T2; d0 = d1; d1 = d2;
#pragma unroll
        for (int i = 0; i < 4; ++i) { c0[i] = c1[i]; c1[i] = c2[i]; }
    }
}
DI void norm_mod_phase(CP P, int l, int which, int nrows, LP lds) {
    const int tid = tid_l(), lane = tid & 63, wave = tid >> 6, gw = bid_l() * 8 + wave, nw = gridDim.x * 8;
    unsigned char* ws = P->ws; float* X = (float*)(ws + WS_X); bf16_t* H = (bf16_t*)(ws + WS_H);
    const bool fin = (gridDim.x == 256) && ((l == 0 && which == 1) || (l == 1 && which == 0));
    PG8_LAS int* tbl = (PG8_LAS int*)lds;
    if (fin) { for (int i = tid; i < 576; i += NTHR) tbl[i] = -1;
        __syncthreads();
        if (tid < 64) { pg8::StaticOrder S; S.init(MT, D, 256, tid); Unit u; if (S.next(2, u)) tbl[u.pm * 8 + u.pn] = tid; }
        __syncthreads(); }
    const float* XPp = (const float*)(ws + WS_XP);
    const float* g = (which ? P->in[I_N2G] : P->in[I_N1G]) + l * D;
#define NM_XROW(r_) ((l == 0 && which == 0) ? ((r_) < NLAT ? P->in[I_X] + (size_t)(r_) * D : P->in[I_CTX] + (size_t)((r_) - NLAT) * D) : X + (size_t)(r_) * D)
    const int rpw = (nrows + nw - 1) / nw, r0 = gw * rpw, r1 = (r0 + rpw) < nrows ? (r0 + rpw) : nrows;
    f32x4 v[8], ga[8], gb[8]; int bcur = -1;
    if (r0 < r1) { const float* xr0 = NM_XROW(r0);
#pragma unroll
        for (int i = 0; i < 8; ++i) v[i] = *(const f32x4*)(xr0 + 4 * lane + 256 * i); }
    for (int r = r0; r < r1; ++r) {
        const int rn = r + 1; f32x4 vn[8];
        if (rn < r1) { const float* xrn = NM_XROW(rn);
#pragma unroll
            for (int i = 0; i < 8; ++i) vn[i] = *(const f32x4*)(xrn + 4 * lane + 256 * i); }
        const int b = r < NLAT ? (r >> 11) : 8;
        if (b != bcur) { bcur = b;
            const float* sh = (const float*)(ws + WS_MOD) + (((size_t)l * 9 + b) * 6 + (which ? 3 : 0)) * D; const float* sc = sh + D;
#pragma unroll
            for (int i = 0; i < 8; ++i) { const int col = 4 * lane + 256 * i; ga[i] = *(const f32x4*)(g + col) * (1.0f + *(const f32x4*)(sc + col)); gb[i] = *(const f32x4*)(sh + col); } }
        float ss = 0.f;
#pragma unroll
        for (int i = 0; i < 8; ++i) {
            if (fin) { const int t = tbl[(r >> 8) * 8 + i];
                if (t >= 0) { const float* xp = XPp + ((size_t)(t * 3) << 16) + (size_t)(r & 255) * 256 + 4 * lane;
                    v[i] += *(const f32x4*)xp + *(const f32x4*)(xp + 65536) + *(const f32x4*)(xp + 131072);
                    *(f32x4*)(X + (size_t)r * D + 4 * lane + 256 * i) = v[i]; } }
            ss += v[i][0] * v[i][0] + v[i][1] * v[i][1] + v[i][2] * v[i][2] + v[i][3] * v[i][3]; }
#pragma unroll
        for (int o = 32; o >= 1; o >>= 1) ss += __shfl_xor(ss, o);
        const float rstd = rsqrtf(ss * (1.0f / D) + EPS);
        if (which == 0 && lane == 0) ((float*)(ws + WS_SSQ))[r] = 0.f;
#pragma unroll
        for (int i = 0; i < 8; ++i) { const int col = 4 * lane + 256 * i;
            const f32x4 h = v[i] * rstd * ga[i] + gb[i]; u32x2 w; w.x = pk2(h[0], h[1]); w.y = pk2(h[2], h[3]);
            *(u32x2*)(H + (size_t)r * D + col) = w; }
#pragma unroll
        for (int i = 0; i < 8; ++i) v[i] = vn[i];
    }
#undef NM_XROW
}
DI void final_norm_phase(CP P) {
    const int tid = tid_l(), lane = tid & 63, wave = tid >> 6, gw = bid_l() * 8 + wave, nw = gridDim.x * 8;
    const float* X = (const float*)(P->ws + WS_X); const float* g = P->in[I_FNG];
    const int rpw = (NLAT + nw - 1) / nw, r0 = gw * rpw, r1 = (r0 + rpw) < NLAT ? (r0 + rpw) : NLAT;
    f32x4 v[8], gg[8];
#pragma unroll
    for (int i = 0; i < 8; ++i) gg[i] = *(const f32x4*)(g + 4 * lane + 256 * i);
    if (r0 < r1) {
#pragma unroll
        for (int i = 0; i < 8; ++i) v[i] = *(const f32x4*)(X + (size_t)r0 * D + 4 * lane + 256 * i); }
    for (int r = r0; r < r1; ++r) {
        const int rn = r + 1; f32x4 vn[8];
        if (rn < r1) {
#pragma unroll
            for (int i = 0; i < 8; ++i) vn[i] = *(const f32x4*)(X + (size_t)rn * D + 4 * lane + 256 * i); }
        float ss = 0.f;
#pragma unroll
        for (int i = 0; i < 8; ++i) ss += v[i][0] * v[i][0] + v[i][1] * v[i][1] + v[i][2] * v[i][2] + v[i][3] * v[i][3];
#pragma unroll
        for (int o = 32; o >= 1; o >>= 1) ss += __shfl_xor(ss, o);
        const float rstd = rsqrtf(ss * (1.0f / D) + EPS);
#pragma unroll
        for (int i = 0; i < 8; ++i) __builtin_nontemporal_store(v[i] * rstd * gg[i], (f32x4*)(P->out + (size_t)r * D + 4 * lane + 256 * i));
#pragma unroll
        for (int i = 0; i < 8; ++i) v[i] = vn[i];
    }
}
DI void qk_phase(CP P, int l) {
    const int tid = tid_l(), lane = tid & 63, wave = tid >> 6, j = lane & 15, grp = lane >> 4;
    unsigned char* ws = P->ws; bf16_t* Pb = (bf16_t*)(ws + WS_P); const float* tab = (const float*)(ws + WS_ROPE);
    const int nrows = MT, nw = gridDim.x * 8;
    float qg[8], kg[8];
#pragma unroll
    for (int e = 0; e < 8; ++e) { qg[e] = P->in[I_QNG][l * 128 + 8 * j + e] * QSCALE; kg[e] = P->in[I_KNG][l * 128 + 8 * j + e]; }
    const bool first = (j & 4) == 0;
    for (int row = bid_l() * 8 + wave; row < nrows; row += nw) {
        const bool lat = row < NLAT; const bool qrow = lat || l == 0;
        float cs[8], sn[8];
        if (lat) { const int t = row & 2047, pos = (j & 8) ? (t & 63) : (t >> 6); const float* tp = tab + (size_t)(pos * 32 + 8 * (j & 3)) * 2;
            const f32x4 t0 = *(const f32x4*)tp, t1 = *(const f32x4*)(tp + 4), t2 = *(const f32x4*)(tp + 8), t3 = *(const f32x4*)(tp + 12);
            cs[0] = t0[0]; sn[0] = t0[1]; cs[1] = t0[2]; sn[1] = t0[3]; cs[2] = t1[0]; sn[2] = t1[1]; cs[3] = t1[2]; sn[3] = t1[3];
            cs[4] = t2[0]; sn[4] = t2[1]; cs[5] = t2[2]; sn[5] = t2[3]; cs[6] = t3[0]; sn[6] = t3[1]; cs[7] = t3[2]; sn[7] = t3[3]; }
        else {
#pragma unroll
            for (int e = 0; e < 8; ++e) { cs[e] = 1.f; sn[e] = 0.f; } }
        bf16_t* rp = Pb + (size_t)row * INW + 8 * j;
        u32x4 raw[3]; const bool kact = grp < 2;
        if (qrow) { raw[0] = *(const u32x4*)(rp + grp * 128); raw[1] = *(const u32x4*)(rp + (4 + grp) * 128); }
        const bool kpart = (l == 1 && !lat);
        float kx[8];
        if (kpart) { if (kact) { const float* kp = (const float*)(ws + WS_KVP) + (size_t)(row - NLAT) * 512 + grp * 128 + 8 * j;
                f32x4 a0 = *(const f32x4*)kp, a1 = *(const f32x4*)(kp + 4);
#pragma unroll
                for (int q = 1; q < 4; ++q) { a0 += *(const f32x4*)(kp + (size_t)q * NCTX * 512); a1 += *(const f32x4*)(kp + (size_t)q * NCTX * 512 + 4); }
                kx[0] = a0[0]; kx[1] = a0[1]; kx[2] = a0[2]; kx[3] = a0[3]; kx[4] = a1[0]; kx[5] = a1[1]; kx[6] = a1[2]; kx[7] = a1[3]; }
            else {
#pragma unroll
                for (int e = 0; e < 8; ++e) kx[e] = 0.f; } }
        else raw[2] = *(const u32x4*)(rp + 1024 + (kact ? grp : 0) * 128);
#pragma unroll
        for (int pass = 0; pass < 3; ++pass) {
            if (pass < 2 && !qrow) continue;
            float x[8];
            if (pass == 2 && kpart) {
#pragma unroll
                for (int e = 0; e < 8; ++e) x[e] = kx[e]; }
            else { const u32x4 rw = raw[pass]; x[0] = bf_lo(rw.x); x[1] = bf_hi(rw.x); x[2] = bf_lo(rw.y); x[3] = bf_hi(rw.y); x[4] = bf_lo(rw.z); x[5] = bf_hi(rw.z); x[6] = bf_lo(rw.w); x[7] = bf_hi(rw.w); }
            float ss = 0.f;
#pragma unroll
            for (int e = 0; e < 8; ++e) ss += x[e] * x[e];
            ss += __shfl_xor(ss, 1); ss += __shfl_xor(ss, 2); ss += __shfl_xor(ss, 4); ss += __shfl_xor(ss, 8);
            const float rstd = rsqrtf(ss * (1.0f / 128.0f) + EPS);
            float y[8], yp[8];
#pragma unroll
            for (int e = 0; e < 8; ++e) y[e] = x[e] * rstd * (pass < 2 ? qg[e] : kg[e]);
#pragma unroll
            for (int e = 0; e < 8; ++e) yp[e] = __shfl_xor(y[e], 4);
#pragma unroll
            for (int e = 0; e < 8; ++e) y[e] = first ? (y[e] * cs[e] - yp[e] * sn[e]) : (y[e] * cs[e] + yp[e] * sn[e]);
            u32x4 w; w.x = pk2(y[0], y[1]); w.y = pk2(y[2], y[3]); w.z = pk2(y[4], y[5]); w.w = pk2(y[6], y[7]);
            if (pass == 0) *(u32x4*)(rp + grp * 128) = w;
            else if (pass == 1) *(u32x4*)(rp + (4 + grp) * 128) = w;
            else if (kact) *(u32x4*)(rp + 1024 + grp * 128) = w;
        }
    }
}
DI void vt_phase(CP P, int l, LP lds) {
    const int tid = tid_l(); unsigned char* ws = P->ws; const bf16_t* Pb = (const bf16_t*)(ws + WS_P);
    for (int it = (bid_l() + (int)((gridDim.x * 3) >> 2)) % (int)gridDim.x; it < 288; it += gridDim.x) {
        int rowbase, LV, t0, b; bf16_t* dst;
        if (it < 256) { b = it >> 5; t0 = (it & 31) * 64; rowbase = b * SEQ + t0; LV = SEQ; dst = (bf16_t*)(ws + WS_VTL) + (size_t)b * 2 * 128 * SEQ + t0; }
        else { const int i2 = it - 256; b = i2 >> 2; t0 = (i2 & 3) * 64; rowbase = NLAT + b * CTXL + t0; LV = CTXL; dst = (bf16_t*)(ws + WS_VTC) + (size_t)b * 2 * 128 * CTXL + t0; }
#pragma unroll
        for (int i = 0; i < 4; ++i) { const int idx = tid + 512 * i, row = idx >> 5, c16 = idx & 31;
            u32x4 v;
            if (l == 1 && it >= 256) {
                const float* vp = (const float*)(ws + WS_KVP) + (size_t)(rowbase - NLAT + row) * 512 + 256 + 8 * c16;
                f32x4 a0 = *(const f32x4*)vp, a1 = *(const f32x4*)(vp + 4);
#pragma unroll
                for (int q = 1; q < 4; ++q) { a0 += *(const f32x4*)(vp + (size_t)q * NCTX * 512); a1 += *(const f32x4*)(vp + (size_t)q * NCTX * 512 + 4); }
                v.x = pk2(a0[0], a0[1]); v.y = pk2(a0[2], a0[3]); v.z = pk2(a1[0], a1[1]); v.w = pk2(a1[2], a1[3]);
            } else v = *(const u32x4*)(Pb + (size_t)(rowbase + row) * INW + 1280 + 8 * c16);
            *(PG8_LAS u32x4*)(lds + row * 528 + c16 * 16) = v; }
        __syncthreads();
#pragma unroll
        for (int i = 0; i < 4; ++i) { const int idx = tid + 512 * i, col = idx >> 3, ts = idx & 7;
            unsigned short e[8];
#pragma unroll
            for (int k = 0; k < 8; ++k) e[k] = *(const PG8_LAS unsigned short*)(lds + (8 * ts + k) * 528 + col * 2);
            u32x4 w; w.x = e[0] | ((unsigned)e[1] << 16); w.y = e[2] | ((unsigned)e[3] << 16); w.z = e[4] | ((unsigned)e[5] << 16); w.w = e[6] | ((unsigned)e[7] << 16);
            *(u32x4*)(dst + (size_t)col * LV + 8 * ts) = w; }
        __syncthreads();
    }
}
#define MFMA16(a, b, c) __builtin_amdgcn_mfma_f32_16x16x32_bf16((a), (b), (c), 0, 0, 0)
#define MFMA32(a, b, c) __builtin_amdgcn_mfma_f32_32x32x16_bf16((a), (b), (c), 0, 0, 0)
DI void pool_phase(CP P, int l, LP lds) {
    const int tid = tid_l(), lane = tid & 63, wave = tid >> 6; unsigned char* ws = P->ws;
    const bf16_t* Pb = (const bf16_t*)(ws + WS_P); bf16_t* MIX = (bf16_t*)(ws + WS_MIX);
    const LP raw = lds, Yl = lds + 144 * 272, Wt = lds + 144 * 272 + 128 * 272;
    const int nitems = (l == 0 ? 144 : 128) * 4; int wgi = -1;
    for (int it = bid_l(); it < nitems; it += gridDim.x) {
        const int gi = it & 3, tile = it >> 2, row0 = tile * 128;
        const int L = row0 < NLAT ? SEQ : CTXL, s0 = row0 < NLAT ? (row0 & ~(SEQ - 1)) : NLAT + ((row0 - NLAT) & ~(CTXL - 1)), tpos0 = row0 - s0;
        const int w = 2 << gi;
        { u32x4 rv_[5]; bool ok_[5];
#pragma unroll
          for (int q = 0; q < 5; ++q) { const int i = tid + q * NTHR, rr = i >> 4, c = i & 15, tp = tpos0 - 8 + rr; ok_[q] = (i < 144 * 16) && tp >= 0 && tp < L;
              if (ok_[q]) rv_[q] = *(const u32x4*)(Pb + (size_t)(s0 + tp) * INW + 1536 + gi * 128 + c * 8); }
#pragma unroll
          for (int q = 0; q < 5; ++q) { const int i = tid + q * NTHR, rr = i >> 4, c = i & 15; if (ok_[q]) *(PG8_LAS u32x4*)(raw + rr * 272 + c * 16) = rv_[q]; } }
        if (gi != wgi) { wgi = gi;
            const float* pw = P->in[I_POOLW] + ((size_t)l * 4 + gi) * 128 * 128;
            f32x4 wv_[8];
#pragma unroll
            for (int q = 0; q < 8; ++q) { const int i = tid + q * NTHR; wv_[q] = *(const f32x4*)(pw + (i >> 5) * 128 + (i & 31) * 4); }
#pragma unroll
            for (int q = 0; q < 8; ++q) { const int i = tid + q * NTHR, c = i >> 5, d4 = (i & 31) * 4;
#pragma unroll
                for (int e = 0; e < 4; ++e) *(PG8_LAS unsigned short*)(Wt + (d4 + e) * 272 + c * 2) = (unsigned short)(pk2(wv_[q][e], 0.f) & 0xffffu); } }
        __syncthreads();
        { const int t = tid >> 2, cs = (tid & 3) * 32, tp = tpos0 + t;
          int lo = tp - (w >> 1), hi = lo + w; lo = lo < 0 ? 0 : lo; hi = hi > L ? L : hi; const float inv = 1.0f / (float)(hi - lo);
#pragma unroll
          for (int q = 0; q < 4; ++q) { float sum[8];
#pragma unroll
              for (int e = 0; e < 8; ++e) sum[e] = 0.f;
              for (int tt = lo; tt < hi; ++tt) { const u32x4 v = *(const PG8_LAS u32x4*)(raw + (tt - tpos0 + 8) * 272 + (cs + 8 * q) * 2);
                  sum[0] += bf_lo(v.x); sum[1] += bf_hi(v.x); sum[2] += bf_lo(v.y); sum[3] += bf_hi(v.y); sum[4] += bf_lo(v.z); sum[5] += bf_hi(v.z); sum[6] += bf_lo(v.w); sum[7] += bf_hi(v.w); }
              const u32x4 sv = *(const PG8_LAS u32x4*)(raw + (t + 8) * 272 + (cs + 8 * q) * 2);
              u32x4 o; o.x = pk2(sum[0] * inv - bf_lo(sv.x), sum[1] * inv - bf_hi(sv.x)); o.y = pk2(sum[2] * inv - bf_lo(sv.y), sum[3] * inv - bf_hi(sv.y));
              o.z = pk2(sum[4] * inv - bf_lo(sv.z), sum[5] * inv - bf_hi(sv.z)); o.w = pk2(sum[6] * inv - bf_lo(sv.w), sum[7] * inv - bf_hi(sv.w));
              *(PG8_LAS u32x4*)(Yl + t * 272 + (cs + 8 * q) * 2) = o; } }
        __syncthreads();
        { f32x4 acc[8];
#pragma unroll
          for (int dt = 0; dt < 8; ++dt) acc[dt] = (f32x4){0.f, 0.f, 0.f, 0.f};
          const int li = lane & 15, lq = lane >> 4;
#pragma unroll
          for (int ks = 0; ks < 4; ++ks) { const bf16x8 bfr = *(const PG8_LAS bf16x8*)(Yl + (16 * wave + li) * 272 + (32 * ks + 8 * lq) * 2);
#pragma unroll
              for (int dt = 0; dt < 8; ++dt) { const bf16x8 afr = *(const PG8_LAS bf16x8*)(Wt + (16 * dt + li) * 272 + (32 * ks + 8 * lq) * 2); acc[dt] = MFMA16(afr, bfr, acc[dt]); } }
          const int token = row0 + 16 * wave + li; const float* psc = P->in[I_POOLS] + l * 512 + gi * 128 + 4 * lq;
          f32x4 sc_[8];
#pragma unroll
          for (int dt = 0; dt < 8; ++dt) sc_[dt] = *(const f32x4*)(psc + 16 * dt);
#pragma unroll
          for (int dt = 0; dt < 8; ++dt) { const f32x4 o = acc[dt] * sc_[dt]; u32x2 wv; wv.x = pk2(o[0], o[1]); wv.y = pk2(o[2], o[3]);
              *(u32x2*)(MIX + (size_t)token * D + 1024 + gi * 128 + 16 * dt + 4 * lq) = wv; } }
        __syncthreads();
    }
}
DI void sgu_phase(CP P, int l, LP lds) {
    const int tid = tid_l(), lane = tid & 63, wave = tid >> 6; unsigned char* ws = P->ws;
    const bf16_t* Pb = (const bf16_t*)(ws + WS_P); bf16_t* MIX = (bf16_t*)(ws + WS_MIX);
    const LP Vt = lds, Wl = lds + 128 * 272;
    const int nitems = (l == 0 ? 144 : 128) * 4; int whh = -1;
    for (int it = (bid_l() + (int)(gridDim.x >> 1)) % (int)gridDim.x; it < nitems; it += gridDim.x) {
        const int hh = it & 3, chunk = it >> 2, row0 = chunk * 128;
        const int q = tid >> 2, part = tid & 3;
        const bf16_t* gr = Pb + (size_t)(row0 + q) * INW + 2560;
        const float ss = ((const float*)(ws + WS_SSQ))[row0 + q];
        const float rstd = rsqrtf(ss * (1.0f / 512.0f) + EPS);
        const float* gn = P->in[I_SGUNG] + l * 512 + hh * 128 + part * 32;
#pragma unroll
        for (int i = 0; i < 4; ++i) { const u32x4 v = *(const u32x4*)(gr + hh * 128 + part * 32 + 8 * i);
            const f32x4 a = (f32x4){bf_lo(v.x), bf_hi(v.x), bf_lo(v.y), bf_hi(v.y)}, b = (f32x4){bf_lo(v.z), bf_hi(v.z), bf_lo(v.w), bf_hi(v.w)};
            const f32x4 g0 = *(const f32x4*)(gn + 8 * i), g1 = *(const f32x4*)(gn + 8 * i + 4);
            const int c0 = part * 32 + 8 * i;
#pragma unroll
            for (int e = 0; e < 4; ++e) { *(PG8_LAS unsigned short*)(Vt + (c0 + e) * 272 + q * 2) = (unsigned short)(pk2(a[e] * rstd * g0[e], 0.f) & 0xffffu);
                                          *(PG8_LAS unsigned short*)(Vt + (c0 + 4 + e) * 272 + q * 2) = (unsigned short)(pk2(b[e] * rstd * g1[e], 0.f) & 0xffffu); } }
        if (hh != whh) { whh = hh;
            const float* sw = P->in[I_SGUW] + ((size_t)l * 4 + hh) * 128 * 128;
            f32x4 wv_[8];
#pragma unroll
            for (int q = 0; q < 8; ++q) { const int i = tid + q * NTHR; wv_[q] = *(const f32x4*)(sw + (i >> 5) * 128 + (i & 31) * 4); }
#pragma unroll
            for (int q = 0; q < 8; ++q) { const int i = tid + q * NTHR, pp = i >> 5, q4 = (i & 31) * 4;
                u32x2 o; o.x = pk2(wv_[q][0], wv_[q][1]); o.y = pk2(wv_[q][2], wv_[q][3]); *(PG8_LAS u32x2*)(Wl + pp * 272 + q4 * 2) = o; } }
        __syncthreads();
        { f32x4 acc[8];
#pragma unroll
          for (int ct = 0; ct < 8; ++ct) acc[ct] = (f32x4){0.f, 0.f, 0.f, 0.f};
          const int li = lane & 15, lq = lane >> 4;
#pragma unroll
          for (int ks = 0; ks < 4; ++ks) { const bf16x8 wfr = *(const PG8_LAS bf16x8*)(Wl + (16 * wave + li) * 272 + (32 * ks + 8 * lq) * 2);
#pragma unroll
              for (int ct = 0; ct < 8; ++ct) { const bf16x8 vfr = *(const PG8_LAS bf16x8*)(Vt + (16 * ct + li) * 272 + (32 * ks + 8 * lq) * 2); acc[ct] = MFMA16(vfr, wfr, acc[ct]); } }
          const int pl = 16 * wave + li, token = row0 + pl; const float bias = P->in[I_SGUB][(l * 4 + hh) * 128 + pl];
          const bf16_t* up = Pb + (size_t)token * INW + 2048 + hh * 128 + 4 * lq;
          u32x2 uv_[8];
#pragma unroll
          for (int ct = 0; ct < 8; ++ct) uv_[ct] = *(const u32x2*)(up + 16 * ct);
#pragma unroll
          for (int ct = 0; ct < 8; ++ct) { const u32x2 uv = uv_[ct]; const f32x4 ug = (f32x4){bf_lo(uv.x), bf_hi(uv.x), bf_lo(uv.y), bf_hi(uv.y)};
              const f32x4 o = ug * (acc[ct] + bias); u32x2 wv; wv.x = pk2(o[0], o[1]); wv.y = pk2(o[2], o[3]);
              *(u32x2*)(MIX + (size_t)token * D + 1536 + hh * 128 + 16 * ct + 4 * lq) = wv; } }
        __syncthreads();
    }
}
DI void attn_phase(CP P, int l, LP lds) {
    const int tid = tid_l(), lane = tid & 63, wave = tid >> 6, r = lane & 31, h = lane >> 5; unsigned char* ws = P->ws;
    const bf16_t* Pb = (const bf16_t*)(ws + WS_P); bf16_t* MIX = (bf16_t*)(ws + WS_MIX);
    const bf16_t* VTL = (const bf16_t*)(ws + WS_VTL); const bf16_t* VTC = (const bf16_t*)(ws + WS_VTC);
    constexpr int ATT_BUF = 64 * 272 + 128 * 144;
    const LP Kl = lds, Vl = lds + 64 * 272;
    const int nitems = l == 0 ? 576 : 512;
    for (int it = bid_l(); it < nitems; it += gridDim.x) {
        const bool isctx = it >= 512; int b, n, kh, hp;
        if (!isctx) { hp = it & 1; kh = (it >> 1) & 1; n = (it >> 2) & 15; b = it >> 6; } else { const int i2 = it - 512; hp = i2 & 1; kh = (i2 >> 1) & 1; n = (i2 >> 2) & 1; b = i2 >> 3; }
        const int qrow0 = isctx ? NLAT + b * CTXL + n * 128 : b * SEQ + n * 128;
        const int hq = kh * 4 + hp * 2 + (wave >> 2), qsub = wave & 3, myrow = qrow0 + qsub * 32 + r;
        bf16x8 qf[8];
#pragma unroll
        for (int ks = 0; ks < 8; ++ks) qf[ks] = *(const bf16x8*)(Pb + (size_t)myrow * INW + hq * 128 + 16 * ks + 8 * h);
        const int kb_lo = n > 0 ? n - 1 : 0, kb_hi = n < 15 ? n + 1 : 15;
        const int nband = isctx ? 0 : (kb_hi - kb_lo + 1) * 2, nch = nband + 4;
        float m = P->in[I_SINK][l * 8 + hq] * LOG2E, lsum = 1.0f;
        f32x16 O[4];
#pragma unroll
        for (int dt = 0; dt < 4; ++dt)
#pragma unroll
            for (int i = 0; i < 16; ++i) O[dt][i] = 0.f;
        u32x4 pre[4];
        const bf16_t* Kc_base = Pb + (size_t)(NLAT + b * CTXL) * INW + 1024 + kh * 128;
        const bf16_t* Kb_base = Pb + (size_t)(b * SEQ) * INW + 1024 + kh * 128;
        const bf16_t* Vc_base = VTC + (size_t)(b * 2 + kh) * 128 * CTXL;
        const bf16_t* Vb_base = VTL + (size_t)(b * 2 + kh) * 128 * SEQ;
#define ATT_LOAD(c) do { const bool band_ = (c) < nband; const int key0_ = band_ ? kb_lo * 128 + (c) * 64 : ((c) - nband) * 64; \
            const bf16_t* kb_ = band_ ? Kb_base : Kc_base; const bf16_t* vb_ = band_ ? Vb_base : Vc_base; const int lv_ = band_ ? SEQ : CTXL; \
            _Pragma("unroll") for (int i_ = 0; i_ < 2; ++i_) { const int p_ = tid + 512 * i_; \
                pre[i_] = *(const u32x4*)(kb_ + (size_t)(key0_ + (p_ >> 4)) * INW + (p_ & 15) * 8); \
                pre[2 + i_] = *(const u32x4*)(vb_ + (size_t)(p_ >> 3) * lv_ + key0_ + (p_ & 7) * 8); } } while (0)
        ATT_LOAD(0);
        __syncthreads();
#pragma unroll
        for (int i = 0; i < 2; ++i) { const int p = tid + 512 * i; *(PG8_LAS u32x4*)(Kl + (p >> 4) * 272 + (p & 15) * 16) = pre[i]; *(PG8_LAS u32x4*)(Vl + (p >> 3) * 144 + (p & 7) * 16) = pre[2 + i]; }
        __syncthreads();
        for (int c = 0; c < nch; ++c) {
            const LP Kc = Kl + (c & 1) * ATT_BUF, Vc = Vl + (c & 1) * ATT_BUF;
            if (c + 1 < nch) ATT_LOAD(c + 1);
            bool skip = false; int kblk = n;
            if (c < nband) { kblk = kb_lo + (c >> 1);
                if (kblk < n) skip = ((c & 1) == 0) && (qsub >= 2);
                else if (kblk > n) skip = ((c & 1) == 1) && (qsub < 2); }
            if (!skip) {
            f32x16 S0, S1;
#pragma unroll
            for (int i = 0; i < 16; ++i) { S0[i] = 0.f; S1[i] = 0.f; }
#pragma unroll
            for (int ks = 0; ks < 8; ++ks) { const bf16x8 k0 = *(const PG8_LAS bf16x8*)(Kc + r * 272 + (16 * ks + 8 * h) * 2), k1 = *(const PG8_LAS bf16x8*)(Kc + (32 + r) * 272 + (16 * ks + 8 * h) * 2);
                S0 = MFMA32(k0, qf[ks], S0); S1 = MFMA32(k1, qf[ks], S1); }
            const bool allvalid = (kblk < n) ? (((c & 1) == 1) && (qsub < 2)) : (((c & 1) == 0) && (qsub >= 2));
            if (kblk != n && !allvalid) { const int qi = n * 128 + qsub * 32 + r, kj0 = kblk * 128 + (c & 1) * 64 + 4 * h;
#pragma unroll
                for (int i = 0; i < 16; ++i) { const int kj = kj0 + (i & 3) + 8 * (i >> 2); int dd = qi - kj; dd = dd < 0 ? -dd : dd;
                    if (dd > 128) S0[i] = -1e30f; int d2 = qi - (kj + 32); d2 = d2 < 0 ? -d2 : d2; if (d2 > 128) S1[i] = -1e30f; } }
            float cmax = S0[0];
#pragma unroll
            for (int i = 1; i < 16; ++i) cmax = fmaxf(cmax, S0[i]);
#pragma unroll
            for (int i = 0; i < 16; ++i) cmax = fmaxf(cmax, S1[i]);
            { const auto r_ = __builtin_amdgcn_permlane32_swap(__float_as_uint(cmax), __float_as_uint(cmax), false, false); cmax = fmaxf(__uint_as_float(r_[0]), __uint_as_float(r_[1])); }
            const bool grew = cmax > m + 8.0f; const float mnew = grew ? cmax : m, alpha = __builtin_amdgcn_exp2f(m - mnew); m = mnew;
            float rs = 0.f;
#pragma unroll
            for (int i = 0; i < 16; ++i) { S0[i] = __builtin_amdgcn_exp2f(S0[i] - mnew); S1[i] = __builtin_amdgcn_exp2f(S1[i] - mnew); rs += S0[i] + S1[i]; }
            { const auto r_ = __builtin_amdgcn_permlane32_swap(__float_as_uint(rs), __float_as_uint(rs), false, false); rs = __uint_as_float(r_[0]) + __uint_as_float(r_[1]); }
            lsum = lsum * alpha + rs;
            if (__any(grew)) {
#pragma unroll
                for (int dt = 0; dt < 4; ++dt)
#pragma unroll
                    for (int i = 0; i < 16; ++i) O[dt][i] *= alpha; }
            bf16x8 pf[2][2];
#pragma unroll
            for (int s = 0; s < 2; ++s) { u32x4 a, bq;
                a.x = pk2(S0[8 * s + 0], S0[8 * s + 1]); a.y = pk2(S0[8 * s + 2], S0[8 * s + 3]); a.z = pk2(S0[8 * s + 4], S0[8 * s + 5]); a.w = pk2(S0[8 * s + 6], S0[8 * s + 7]);
                bq.x = pk2(S1[8 * s + 0], S1[8 * s + 1]); bq.y = pk2(S1[8 * s + 2], S1[8 * s + 3]); bq.z = pk2(S1[8 * s + 4], S1[8 * s + 5]); bq.w = pk2(S1[8 * s + 6], S1[8 * s + 7]);
                pf[0][s] = __builtin_bit_cast(bf16x8, a); pf[1][s] = __builtin_bit_cast(bf16x8, bq); }
#pragma unroll
            for (int dt = 0; dt < 4; ++dt)
#pragma unroll
                for (int kt = 0; kt < 2; ++kt)
#pragma unroll
                    for (int s = 0; s < 2; ++s) { const LP vp = Vc + (32 * dt + r) * 144 + (32 * kt + 16 * s + 4 * h) * 2;
                        const u32x2 lo = *(const PG8_LAS u32x2*)vp, hi = *(const PG8_LAS u32x2*)(vp + 16);
                        u32x4 vv; vv.x = lo.x; vv.y = lo.y; vv.z = hi.x; vv.w = hi.y;
                        O[dt] = MFMA32(__builtin_bit_cast(bf16x8, vv), pf[kt][s], O[dt]); }
            }
            if (c + 1 < nch) {
                const LP Kn = Kl + ((c + 1) & 1) * ATT_BUF, Vn = Vl + ((c + 1) & 1) * ATT_BUF;
#pragma unroll
                for (int i = 0; i < 2; ++i) { const int p = tid + 512 * i; *(PG8_LAS u32x4*)(Kn + (p >> 4) * 272 + (p & 15) * 16) = pre[i]; *(PG8_LAS u32x4*)(Vn + (p >> 3) * 144 + (p & 7) * 16) = pre[2 + i]; }
            }
            __syncthreads();
        }
#undef ATT_LOAD
        const float inv = 1.0f / lsum;
        bf16_t* op = MIX + (size_t)myrow * D + hq * 128 + 4 * h;
#pragma unroll
        for (int dt = 0; dt < 4; ++dt)
#pragma unroll
            for (int g = 0; g < 4; ++g) { u32x2 wv; wv.x = pk2(O[dt][4 * g] * inv, O[dt][4 * g + 1] * inv); wv.y = pk2(O[dt][4 * g + 2] * inv, O[dt][4 * g + 3] * inv);
                *(u32x2*)(op + 32 * dt + 8 * g) = wv; }
    }
}
DI void fixup_phase(CP P, int l) {
    unsigned char* ws = P->ws; const float* hb = (const float*)(ws + WS_HB); bf16_t* act = (bf16_t*)(ws + WS_ACT);
    const float* cw = P->in[I_CONVW] + (size_t)l * 3 * NUP; const float* cb = P->in[I_CONVB] + (size_t)l * NUP;
    const int nbd = l == 0 ? 128 : 120, total = nbd * (DFF / 4);
    for (int i = bid_l() * NTHR + tid_l(); i < total; i += gridDim.x * NTHR) {
        const int bd = i / (DFF / 4), ch = (i % (DFF / 4)) * 4;
        int blkB; if (bd < 120) { const int b = bd / 15, k = bd % 15 + 1; blkB = b * 16 + k; } else { blkB = 128 + 2 * (bd - 120) + 1; }
        const int blkA = blkB - 1, pn = ch >> 7, cl = ch & 127, ig = pn * 256 + cl, iv = ig + 128;
        const float* A2 = hb + ((size_t)blkA * 4 + 2) * NUP; const float* A3 = A2 + NUP; const float* B0 = hb + ((size_t)blkB * 4) * NUP; const float* B1 = B0 + NUP;
        const f32x4 gm2 = *(const f32x4*)(A2 + ig), gm1 = *(const f32x4*)(A3 + ig), g0 = *(const f32x4*)(B0 + ig), g1 = *(const f32x4*)(B1 + ig);
        const f32x4 vm2 = *(const f32x4*)(A2 + iv), vm1 = *(const f32x4*)(A3 + iv), v0 = *(const f32x4*)(B0 + iv), v1 = *(const f32x4*)(B1 + iv);
        const f32x4 w0g = *(const f32x4*)(cw + ch), w1g = *(const f32x4*)(cw + NUP + ch), w2g = *(const f32x4*)(cw + 2 * NUP + ch), bg = *(const f32x4*)(cb + ch);
        const f32x4 w0v = *(const f32x4*)(cw + DFF + ch), w1v = *(const f32x4*)(cw + NUP + DFF + ch), w2v = *(const f32x4*)(cw + 2 * NUP + DFF + ch), bv = *(const f32x4*)(cb + DFF + ch);
        const f32x4 cgA = bg + w0g * gm2 + w1g * gm1 + w2g * g0, cvA = bv + w0v * vm2 + w1v * vm1 + w2v * v0;
        const f32x4 cgB = bg + w0g * gm1 + w1g * g0 + w2g * g1, cvB = bv + w0v * vm1 + w1v * v0 + w2v * v1;
        f32x4 oA, oB;
#pragma unroll
        for (int e = 0; e < 4; ++e) { oA[e] = silu_f(cgA[e]) * cvA[e]; oB[e] = silu_f(cgB[e]) * cvB[e]; }
        u32x2 wa, wb; wa.x = pk2(oA[0], oA[1]); wa.y = pk2(oA[2], oA[3]); wb.x = pk2(oB[0], oB[1]); wb.y = pk2(oB[2], oB[3]);
        const size_t rowB = (size_t)blkB * 128;
        *(u32x2*)(act + (rowB - 1) * DFF + ch) = wa; *(u32x2*)(act + rowB * DFF + ch) = wb;
    }
}
#ifndef GEMM_ALIGN
#define GEMM_ALIGN true
#endif
#ifndef GEMM_SP2
#define GEMM_SP2 true
#endif
#define GEMM_CALL(EpiT, g, S, E) pg8::gemm_phase<EpiT, pg8::StaticOrder, GEMM_ALIGN, GEMM_SP2>(lds, g, S, E)
DI void gemm_in_phase(CP P, int l, LP lds, bool subset = false) {
    unsigned char* ws = P->ws; const bf16_t* H = (const bf16_t*)(ws + WS_H); const bf16_t* W = (const bf16_t*)(ws + WS_WIN + l * SZ_WIN); bf16_t* Pb = (bf16_t*)(ws + WS_P);
    { pg8::Gemm g; EpiP E; E.O = Pb; E.ldc = INW; g.A = H; g.Bt = W; g.M = l == 0 ? MT : NLAT; g.N = INW; g.K = D; E.row_off = 0; E.col_off = 0; E.gelu_from_pn = 8; E.ssq = (float*)(ws + WS_SSQ);
      pg8::StaticOrder S; S.init(g.M, g.N, gridDim.x, bid_l()); S.nkt = g.K / 64;
      if (subset) { const int b_ = bid_l(); if ((b_ >> 3) & 1) { S.init(g.M, g.N, 128, 0); S.nwg = 0; } else S.init(g.M, g.N, 128, (b_ >> 4) * 8 + (b_ & 7)); S.nkt = g.K / 64; }
      GEMM_CALL(EpiP, g, S, E); }
    if (l == 1) {
        pg8::Gemm g; g.A = H + (size_t)NLAT * D; g.Bt = W + (size_t)1024 * D; g.M = NCTX; g.N = 512; g.K = D;
        EpiKVPart E; E.kvp = (float*)(ws + WS_KVP);
        pg8::StaticOrder S; S.init(g.M, g.N, gridDim.x, bid_l()); S.nkt = g.K / 64; S.split = 1;
        GEMM_CALL(EpiKVPart, g, S, E);
        filler_phase(P, 3, lds);
    }
}
DI void gemm_res_phase(CP P, int l, int which, LP lds) {
    unsigned char* ws = P->ws; float* X = (float*)(ws + WS_X);
    pg8::Gemm g; g.M = l == 0 ? MT : NLAT; g.N = D;
    if (which == 0) { g.A = (const bf16_t*)(ws + WS_MIX); g.Bt = (const bf16_t*)(ws + WS_WOUT + l * SZ_WOUT); g.K = D; }
    else { g.A = (const bf16_t*)(ws + WS_ACT); g.Bt = (const bf16_t*)(ws + WS_WDN + l * SZ_WDN); g.K = DFF; }
    EpiRes E; E.out = X; E.gate = (const float*)(ws + WS_MOD) + ((size_t)l * 9 * 6 + (which ? 5 : 2)) * D;
    if (l == 0 && which == 0) { E.base_lat = P->in[I_X]; E.base_ctx = P->in[I_CTX]; } else { E.base_lat = X; E.base_ctx = X + (size_t)NLAT * D; }
    pg8::StaticOrder S; S.init(g.M, g.N, gridDim.x, bid_l()); S.nkt = g.K / 64; S.split = (gridDim.x == 256 && l == 0) ? 1 : 0;
    E.xpart = (float*)(ws + WS_XP);
    GEMM_CALL(EpiRes, g, S, E);
}
DI void gemm_up_phase(CP P, int l, LP lds) {
    unsigned char* ws = P->ws;
    pg8::Gemm g; g.A = (const bf16_t*)(ws + WS_H); g.Bt = (const bf16_t*)(ws + WS_WUP + l * SZ_WUP); g.M = l == 0 ? MT : NLAT; g.N = NUP; g.K = D;
    EpiConvGlu E; E.act = (bf16_t*)(ws + WS_ACT); E.hb = (float*)(ws + WS_HB); E.cw = P->in[I_CONVW] + (size_t)l * 3 * NUP; E.cb = P->in[I_CONVB] + (size_t)l * NUP;
    pg8::StaticOrder S; S.init(g.M, g.N, gridDim.x, bid_l()); S.nkt = g.K / 64;
    GEMM_CALL(EpiConvGlu, g, S, E);
}
__global__ void __launch_bounds__(NTHR, 2) fwd_kernel(Params Parg) {
    extern __shared__ __attribute__((aligned(16))) unsigned char lds_raw[];
    const LP lds = (LP)lds_raw;
    cg::grid_group grid = cg::this_grid();
    const int lo = Parg.ph_lo, hi = Parg.ph_hi; int ph = 0;
    if (lo < 0) grid.sync();
    volatile PG8_LAS unsigned* xst = (volatile PG8_LAS unsigned*)(lds + 131072);
    if (threadIdx.x < 4) xst[threadIdx.x] = 0u;
    __syncthreads();
    XcdBarrier xbar = xcd_barrier_post((unsigned*)(Parg.ws + WS_BAR), xst);
#ifndef REP_MASK
#define REP_MASK 0u
#endif
#ifndef EXTRA_SYNCS
#define EXTRA_SYNCS 0
#endif
#ifndef PH_MASK
#define PH_MASK 0xffffffffu
#endif
#define PHASE(id, body) do { if (ph >= lo && ph < hi) { if ((PH_MASK >> (id)) & 1u) { auto kp_ = __builtin_amdgcn_kernarg_segment_ptr(); asm volatile("" : "+s"(kp_)); const CP P = (CP)kp_; body; if ((REP_MASK >> (id)) & 1u) { xcd_barrier(xbar); body; } } if (ph + 1 < hi) xcd_barrier(xbar); for (int xs_ = 0; xs_ < EXTRA_SYNCS; ++xs_) xcd_barrier(xbar); } ++ph; } while (0)
    PHASE(0, prep_phase(P, lds));
#pragma nounroll
    for (int l = 0; l < 2; ++l) {
        const int M = l == 0 ? MT : NLAT;
        PHASE(1, norm_mod_phase(P, l, 0, MT, lds));
        do { if (ph >= lo && ph < hi) { { auto kp_ = __builtin_amdgcn_kernarg_segment_ptr(); asm volatile("" : "+s"(kp_)); const CP P = (CP)kp_; gemm_in_phase(P, l, lds); if (l == 0) filler_phase(P, 0, lds); }
#ifdef SUBSET_PROBE
            xcd_barrier(xbar); { auto kp_ = __builtin_amdgcn_kernarg_segment_ptr(); asm volatile("" : "+s"(kp_)); const CP P = (CP)kp_; gemm_in_phase(P, l, lds, true); }
#endif
            if (ph + 1 < hi) xcd_barrier(xbar); } ++ph; } while (0);
        PHASE(3, { if ((PH_MASK >> 11) & 1u) qk_phase(P, l); for (int rp_ = 0; rp_ <= (int)((REP_MASK >> 12) & 1u); ++rp_) vt_phase(P, l, lds); for (int rp_ = 0; rp_ <= (int)((REP_MASK >> 13) & 1u); ++rp_) pool_phase(P, l, lds); for (int rp_ = 0; rp_ <= (int)((REP_MASK >> 14) & 1u); ++rp_) sgu_phase(P, l, lds); });
        PHASE(4, { attn_phase(P, l, lds); if (l == 0) filler_phase(P, 2, lds); });
        PHASE(5, { gemm_res_phase(P, l, 0, lds); });
        PHASE(6, norm_mod_phase(P, l, 1, M, lds));
        PHASE(7, { gemm_up_phase(P, l, lds); if (l == 0) filler_phase(P, 1, lds); });
        PHASE(8, fixup_phase(P, l));
        PHASE(9, { gemm_res_phase(P, l, 1, lds); });
    }
    PHASE(10, final_norm_phase(P));
#undef PHASE
}
constexpr int N_PHASES = 20;

extern "C" void kernel_launch(void* const* d_in, const int* in_sizes, int n_in, void* d_out, int out_size, void* d_ws, size_t ws_size, hipStream_t stream) {
    static int grid = 0;
    if (grid == 0) {
        if (n_in != N_IN || ws_size < WS_END) { fprintf(stderr, "kernel_launch: need %d inputs and >= %zu bytes of workspace; got %d, %zu\n", (int)N_IN, (size_t)WS_END, n_in, ws_size); grid = -1; return; }
        int dev = 0, cus = 0, per_cu = 0;
        if (hipGetDevice(&dev) != hipSuccess || hipDeviceGetAttribute(&cus, hipDeviceAttributeMultiprocessorCount, dev) != hipSuccess) { fprintf(stderr, "kernel_launch: device query failed\n"); grid = -1; return; }
        if (hipFuncSetAttribute((const void*)fwd_kernel, hipFuncAttributeMaxDynamicSharedMemorySize, LDS_BYTES) != hipSuccess) { fprintf(stderr, "kernel_launch: hipFuncSetAttribute failed\n"); grid = -1; return; }
        if (hipOccupancyMaxActiveBlocksPerMultiprocessor(&per_cu, (const void*)fwd_kernel, NTHR, LDS_BYTES) != hipSuccess || per_cu < 1) { fprintf(stderr, "kernel_launch: occupancy query says %d blocks/CU\n", per_cu); (void)hipGetLastError(); }
        grid = cus;
    }
    if (grid < 0) return;
    if (hipMemsetAsync((unsigned char*)d_ws + WS_BAR, 0, 16384, stream) != hipSuccess) { fprintf(stderr, "kernel_launch: memset of the barrier words failed\n"); return; }
    Params p{};
    for (int i = 0; i < N_IN; ++i) p.in[i] = (const float*)d_in[i];
    p.out = (float*)d_out; p.ws = (unsigned char*)d_ws; p.ph_lo = 0; p.ph_hi = N_PHASES;
    void* args[] = {&p};
    const hipError_t e = hipLaunchCooperativeKernel((const void*)fwd_kernel, dim3(grid), dim3(NTHR), args, LDS_BYTES, stream);
    if (e != hipSuccess) fprintf(stderr, "kernel_launch: cooperative launch failed: %s (grid %d)\n", hipGetErrorString(e), grid);
}
```
